# Optimizing an MI355X kernel written in HIP

```python
import jax, jax.numpy as jnp
from jax import lax
import numpy as np

D_MODEL = 1024
BATCH = 8
SEQ = 2048
DEPTH = 2

N_A = DEPTH // 2
N_B = DEPTH - N_A
CHUNK = 128
A_GROUPS = 8
A_GROUP_DIM = D_MODEL // A_GROUPS
N_HEADS = 16
HEAD_DIM = D_MODEL // N_HEADS
Q_BLOCK = 128
D_FF = 4 * D_MODEL
PLE_DIM = 256
EPS = 1e-6

kernel_name = "yoco_gmlp_stickbreaking_hybrid"


def rms_norm(x, g):
    xf = x.astype(jnp.float32)
    y = xf * lax.rsqrt(jnp.mean(xf * xf, axis=-1, keepdims=True) + EPS)
    return (y * g.astype(jnp.float32)).astype(x.dtype)


def sgu_mixer(h, w_in, g_v, w_s, b_s, w_out):
    bsz, seq, _ = h.shape
    z = jax.nn.gelu(h @ w_in)
    u, v = jnp.split(z, 2, axis=-1)
    v = rms_norm(v, g_v)
    v = v.reshape(bsz, seq // CHUNK, CHUNK, A_GROUPS, A_GROUP_DIM)
    causal = jnp.tril(jnp.ones((CHUNK, CHUNK), dtype=w_s.dtype))
    w = w_s * causal[None]
    mix = jnp.einsum('gts,bcsgd->bctgd', w, v) + jnp.transpose(b_s)[None, None, :, :, None]
    y = u * mix.reshape(bsz, seq, D_MODEL)
    return y @ w_out


def sqrelu_mlp(h, w_up, w_down):
    a = jax.nn.relu(h @ w_up)
    return (a * a) @ w_down


def shared_kv(x, ln_kv, w_kv, g_k):
    bsz, seq, _ = x.shape
    h = rms_norm(x, ln_kv)
    k, v = jnp.split(h @ w_kv, 2, axis=-1)
    k = rms_norm(k.reshape(bsz, seq, N_HEADS, HEAD_DIM), g_k)
    v = v.reshape(bsz, seq, N_HEADS, HEAD_DIM)
    return jnp.transpose(k, (0, 2, 1, 3)), jnp.transpose(v, (0, 2, 1, 3))


def stick_breaking(q, k, v):
    seq = q.shape[2]
    scale = HEAD_DIM ** -0.5
    outs = []
    for blk in range(seq // Q_BLOCK):
        t0 = blk * Q_BLOCK
        t1 = t0 + Q_BLOCK
        qb = q[:, :, t0:t1].astype(jnp.float32)
        kb = k[:, :, :t1].astype(jnp.float32)
        vb = v[:, :, :t1].astype(jnp.float32)
        z = jnp.einsum('bhqd,bhkd->bhqk', qb, kb) * scale
        q_idx = t0 + jnp.arange(Q_BLOCK)[:, None]
        k_idx = jnp.arange(t1)[None, :]
        causal = k_idx < q_idx
        log_1m_beta = jnp.where(causal, jax.nn.log_sigmoid(-z), 0.0)
        between = lax.cumsum(log_1m_beta, axis=3, reverse=True) - log_1m_beta
        a = jnp.where(causal, jnp.exp(jax.nn.log_sigmoid(z) + between), 0.0)
        o = jnp.einsum('bhqk,bhkd->bhqd', a, vb)
        outs.append(o.astype(v.dtype))
    return jnp.concatenate(outs, axis=2)


def stick_breaking_mixer(h, w_q, g_q, k, v, w_out):
    bsz, seq, _ = h.shape
    q = rms_norm((h @ w_q).reshape(bsz, seq, N_HEADS, HEAD_DIM), g_q)
    q = jnp.transpose(q, (0, 2, 1, 3))
    o = stick_breaking(q, k, v)
    o = jnp.transpose(o, (0, 2, 1, 3)).reshape(bsz, seq, D_MODEL)
    return o @ w_out


def setup_inputs(seed: int = 0) -> dict:
    key = jax.random.key(seed)
    ks = jax.random.split(key, 32)

    def nrm(k, shape, scale):
        return jax.random.normal(k, shape, dtype=jnp.float32) * scale

    def gain(k, shape):
        return 1.0 + nrm(k, shape, 0.02)

    return {
        "x": nrm(ks[0], (BATCH, SEQ, D_MODEL), 1.0),
        "p": nrm(ks[1], (DEPTH, BATCH, SEQ, PLE_DIM), 1.0),
        "ln_mix_a": gain(ks[2], (N_A, D_MODEL)),
        "w_in_a": nrm(ks[3], (N_A, D_MODEL, 2 * D_MODEL), D_MODEL ** -0.5),
        "g_v_a": gain(ks[4], (N_A, D_MODEL)),
        "w_spatial": nrm(ks[5], (N_A, A_GROUPS, CHUNK, CHUNK), CHUNK ** -0.5),
        "b_spatial": 1.0 + nrm(ks[6], (N_A, A_GROUPS, CHUNK), 0.02),
        "w_out_a": nrm(ks[7], (N_A, D_MODEL, D_MODEL), D_MODEL ** -0.5),
        "ln_kv": gain(ks[8], (D_MODEL,)),
        "w_kv": nrm(ks[9], (D_MODEL, 2 * D_MODEL), D_MODEL ** -0.5),
        "g_k": gain(ks[10], (HEAD_DIM,)),
        "ln_mix_b": gain(ks[11], (N_B, D_MODEL)),
        "w_q": nrm(ks[12], (N_B, D_MODEL, D_MODEL), D_MODEL ** -0.5),
        "g_q": gain(ks[13], (N_B, HEAD_DIM)),
        "w_out_b": nrm(ks[14], (N_B, D_MODEL, D_MODEL), D_MODEL ** -0.5),
        "ln_mlp": gain(ks[15], (DEPTH, D_MODEL)),
        "w_up": nrm(ks[16], (DEPTH, D_MODEL, D_FF), D_MODEL ** -0.5),
        "w_down": nrm(ks[17], (DEPTH, D_FF, D_MODEL), D_FF ** -0.5),
        "ln_ple": gain(ks[18], (DEPTH, D_MODEL)),
        "w_ple_gate": nrm(ks[19], (DEPTH, D_MODEL, D_MODEL), D_MODEL ** -0.5),
        "w_ple_proj": nrm(ks[20], (DEPTH, PLE_DIM, D_MODEL), PLE_DIM ** -0.5),
    }


def reference(x, p, ln_mix_a, w_in_a, g_v_a, w_spatial, b_spatial, w_out_a,
              ln_kv, w_kv, g_k, ln_mix_b, w_q, g_q, w_out_b,
              ln_mlp, w_up, w_down, ln_ple, w_ple_gate, w_ple_proj):
    k_shared = None
    v_shared = None
    for i in range(DEPTH):
        if i < N_A:
            h = rms_norm(x, ln_mix_a[i])
            x = x + sgu_mixer(h, w_in_a[i], g_v_a[i], w_spatial[i], b_spatial[i], w_out_a[i])
        else:
            j = i - N_A
            h = rms_norm(x, ln_mix_b[j])
            x = x + stick_breaking_mixer(h, w_q[j], g_q[j], k_shared, v_shared, w_out_b[j])
        x = x + sqrelu_mlp(rms_norm(x, ln_mlp[i]), w_up[i], w_down[i])
        gate = jax.nn.sigmoid(rms_norm(x, ln_ple[i]) @ w_ple_gate[i])
        x = x + (p[i] @ w_ple_proj[i]) * gate
        if i == N_A - 1:
            k_shared, v_shared = shared_kv(x, ln_kv, w_kv, g_k)
    return x
```

```cpp
#include <hip/hip_runtime.h>
#include <hip/hip_cooperative_groups.h>
#include <cstdio>
#include <cstdint>
#include <cmath>
namespace cg = cooperative_groups;
namespace pg8 {
#define PG8_LAS __attribute__((address_space(3)))
typedef unsigned short bf16_t;
typedef short bf16x8 __attribute__((ext_vector_type(8)));
typedef float f32x4 __attribute__((ext_vector_type(4)));
typedef unsigned u32x4 __attribute__((ext_vector_type(4)));
typedef unsigned u32x2 __attribute__((ext_vector_type(2)));
constexpr int BM = 256, BK = 64, HALF = 128, HTB = HALF * BK * 2  , STAGE_BYTES = 8 * HTB, NXCD = 8, WGM = 8;

__host__ __device__ __forceinline__ int lds_byte(int r, int c) { const int st = (r >> 4) * 2 + (c >> 5), rr = r & 15, cc = c & 31, ob = rr * 64 + cc * 2; return st * 1024 + (ob ^ (((ob >> 9) & 1) << 5)); }
__host__ __device__ __forceinline__ void stage_rc(int b, int& R, int& C) { const int st = b / 1024, sb = b % 1024, swz = sb ^ (((sb >> 9) & 1) << 5); R = (st >> 1) * 16 + swz / 64; C = (st & 1) * 32 + (swz % 64) / 2; }
__host__ __device__ __forceinline__ int perm32(int rho) { const int n = rho >> 4, i = rho & 15; return 8 * (i >> 2) + 4 * n + (i & 3); }

struct Unit { int pm, pn; };
struct Gemm { const bf16_t* A; const bf16_t* Bt; int M, N, K; };

struct StaticOrder {
    int nM, nN, nwg, G, c;
    __host__ __device__ void init(int M, int N, int G_, int c_) { nM = M / BM; nN = N / BM; nwg = nM * nN; G = G_; c = c_; }
    __host__ __device__ bool next(int i, Unit& u) const {
        const long L = (long)i * G + c; if (L >= nwg) return false;
        int wgid = (int)L; { const int q = nwg / NXCD, r = nwg % NXCD, xcd = wgid % NXCD, off = wgid / NXCD; wgid = (xcd < r ? xcd * (q + 1) : r * (q + 1) + (xcd - r) * q) + off; }
        const int nig = WGM * nN, gid = wgid / nig, fm = gid * WGM, gsz = (nM - fm) < WGM ? (nM - fm) : WGM;
        u.pm = fm + ((wgid % nig) % gsz); u.pn = (wgid % nig) / gsz; return true;
    }
    __device__ __forceinline__ void a_ready(const Unit&) const {}
    __device__ __forceinline__ void done(const Unit&) const {}
};
__device__ __forceinline__ unsigned cvt_pk_bf16(float lo, float hi) { unsigned r; asm volatile("v_cvt_pk_bf16_f32 %0, %1, %2" : "=v"(r) : "v"(lo), "v"(hi)); return r; }
typedef float f32x2 __attribute__((ext_vector_type(2)));
__device__ __forceinline__ void rs8_issue(f32x4 (&v)[2][4], const float* ssq, int row0, int fq) {
#pragma unroll
    for (int ai = 0; ai < 2; ++ai)
#pragma unroll
        for (int m = 0; m < 4; ++m) v[ai][m] = *(const f32x4*)(ssq + (size_t)(row0 + ai * HALF + m * 16) * 16 + 4 * fq);
}
__device__ __forceinline__ void rs8_finish(float (&rs)[2][4], const f32x4 (&v)[2][4]) {
#pragma unroll
    for (int ai = 0; ai < 2; ++ai)
#pragma unroll
        for (int m = 0; m < 4; ++m) { float s = (v[ai][m][0] + v[ai][m][1]) + (v[ai][m][2] + v[ai][m][3]); s += __shfl_xor(s, 16); s += __shfl_xor(s, 32); rs[ai][m] = __builtin_amdgcn_rsqf(s * (1.0f / 1024.0f) + 1e-6f); }
}
template <class Epi, class Sched, bool ALIGN_EPI = false, bool SP2 = false>
__device__ __forceinline__ void gemm_phase(PG8_LAS unsigned char* lds, const Gemm g, const Sched& S, const Epi& E) {
    int tid_ = threadIdx.x; asm volatile("" : "+v"(tid_));
    const int tid = tid_, wid = __builtin_amdgcn_readfirstlane(tid >> 6), lane = tid & 63, wr = wid >> 2, wc = wid & 3, fr = lane & 15, fq = lane >> 4;
    const int K = g.K, nt = K / BK;
    unsigned voffA[2], voffB[2];
#pragma unroll
    for (int i = 0; i < 2; ++i) { int R, C; stage_rc(tid * 16 + i * 8192, R, C); const int Rb = Epi::PERM ? ((R & ~31) + perm32(R & 31)) : R;
        voffA[i] = (unsigned)(R * K + C) * 2u; voffB[i] = (unsigned)(Rb * K + C) * 2u; }
    const size_t kstep = (size_t)(BK * 2);
    const size_t hstep = (size_t)HALF * K * 2;
    const size_t tstep = 2 * hstep;
    const unsigned ldsw = (unsigned)wid * 1024u;
    const int aoff = lds_byte(wr * 64 + fr, fq * 8), boff = lds_byte(wc * 32 + fr, fq * 8);
#define PG8_SA(b, h) (((b) * 2 + (h)) * HTB)
#define PG8_SB(b, h) ((4 + (b) * 2 + (h)) * HTB)
#define PG8_STAGE(bufoff, gbase, voff) do { _Pragma("unroll") for (int _i = 0; _i < 2; ++_i) \
        __builtin_amdgcn_global_load_lds((const unsigned*)((const char*)(gbase) + (voff)[_i]), (PG8_LAS unsigned*)(lds + (bufoff) + ldsw + _i * 8192), 16, 0, 0); } while (0)
#define PG8_LDA(dst, b, h) do { _Pragma("unroll") for (int m = 0; m < 4; ++m) _Pragma("unroll") for (int k = 0; k < 2; ++k) dst[m][k] = *(const PG8_LAS bf16x8*)(lds + PG8_SA(b, h) + aoff + m * 2048 + k * 1024); } while (0)
#define PG8_LDB(dst, b, h) do { _Pragma("unroll") for (int n = 0; n < 2; ++n) _Pragma("unroll") for (int k = 0; k < 2; ++k) dst[n][k] = *(const PG8_LAS bf16x8*)(lds + PG8_SB(b, h) + boff + n * 2048 + k * 1024); } while (0)
#define PG8_MMA(ai, bj, At, Bt) do { __builtin_amdgcn_s_setprio(1); _Pragma("unroll") for (int m = 0; m < 4; ++m) _Pragma("unroll") for (int n = 0; n < 2; ++n) _Pragma("unroll") for (int k = 0; k < 2; ++k) \
        acc[ai][bj][m][n] = __builtin_amdgcn_mfma_f32_16x16x32_bf16(Bt[n][k], At[m][k], acc[ai][bj][m][n], 0, 0, 0); __builtin_amdgcn_s_setprio(0); } while (0)
#define PG8_WAIT_V(n) asm volatile("s_waitcnt vmcnt(" #n ")" ::: "memory")
#define PG8_WAIT_L(n) asm volatile("s_waitcnt lgkmcnt(" #n ")" ::: "memory")
#define PG8_BAR __builtin_amdgcn_s_barrier()
#define PG8_SCHED __builtin_amdgcn_sched_barrier(0)
    Unit cur, nxt; int ui = 0;
    if (!S.next(0, cur)) return;
    f32x4 acc[2][2][4][2];
    float rs8[2][4];
#pragma unroll
    for (int a_ = 0; a_ < 2; ++a_)
#pragma unroll
        for (int m_ = 0; m_ < 4; ++m_) rs8[a_][m_] = 1.0f;
    bf16x8 At[4][2], B0[2][2], B1[2][2];
    const char* cA = (const char*)g.A + (size_t)cur.pm * tstep; const char* cB = (const char*)g.Bt + (size_t)cur.pn * tstep;
    S.a_ready(cur);
    if constexpr (SP2) {
        PG8_STAGE(PG8_SB(0, 0), cB, voffB); PG8_STAGE(PG8_SB(0, 1), cB + hstep, voffB); PG8_STAGE(PG8_SA(0, 0), cA, voffA); PG8_STAGE(PG8_SA(0, 1), cA + hstep, voffA);
        E.init(acc, cur, wr, wc, fr, fq);
        { f32x4 raw_[2][4]; if (E.rs_src()) { rs8_issue(raw_, E.rs_src(), cur.pm * BM + wr * 64 + fr, fq); rs8_finish(rs8, raw_); } }
        if (wr == 1) PG8_BAR;
        PG8_WAIT_V(2); PG8_BAR;
        PG8_STAGE(PG8_SB(1, 0), cB + kstep, voffB); PG8_STAGE(PG8_SA(1, 0), cA + kstep, voffA); PG8_STAGE(PG8_SB(1, 1), cB + hstep + kstep, voffB);
        PG8_WAIT_V(6); PG8_BAR;
    } else {
        PG8_STAGE(PG8_SB(0, 0), cB, voffB); PG8_STAGE(PG8_SA(0, 0), cA, voffA); PG8_STAGE(PG8_SB(0, 1), cB + hstep, voffB); PG8_STAGE(PG8_SA(0, 1), cA + hstep, voffA);
        E.init(acc, cur, wr, wc, fr, fq);
        { f32x4 raw_[2][4]; if (E.rs_src()) { rs8_issue(raw_, E.rs_src(), cur.pm * BM + wr * 64 + fr, fq); rs8_finish(rs8, raw_); } }
        if (wr == 1) PG8_BAR;
        PG8_WAIT_V(4); PG8_BAR;
        PG8_STAGE(PG8_SB(1, 0), cB + kstep, voffB); PG8_STAGE(PG8_SA(1, 0), cA + kstep, voffA); PG8_STAGE(PG8_SB(1, 1), cB + hstep + kstep, voffB);
        PG8_WAIT_V(6); PG8_BAR;
    }
    for (;;) {
        const bool has_next = S.next(ui + 1, nxt);
        const char* nA = has_next ? (const char*)g.A + (size_t)nxt.pm * tstep : cA; const char* nB = has_next ? (const char*)g.Bt + (size_t)nxt.pn * tstep : cB;
        for (int t = 0; t < nt; t += 2) {
            const bool last = (t == nt - 2);
            const char* a1 = cA + (size_t)(t + 1) * kstep;
            const char* a2 = last ? nA : cA + (size_t)(t + 2) * kstep; const char* b2 = last ? nB : cB + (size_t)(t + 2) * kstep;
            const char* a3 = a2 + kstep; const char* b3 = b2 + kstep;
            if (last && has_next) S.a_ready(nxt);
            if constexpr (SP2) {
            PG8_LDB(B0, 0, 0); PG8_LDB(B1, 0, 1); PG8_SCHED; PG8_LDA(At, 0, 0); PG8_STAGE(PG8_SA(1, 1), a1 + hstep, voffA);
            PG8_WAIT_V(8); PG8_WAIT_L(0); PG8_BAR; PG8_MMA(0, 0, At, B0); PG8_MMA(0, 1, At, B1); PG8_BAR; PG8_SCHED;
            PG8_LDA(At, 0, 1); PG8_STAGE(PG8_SB(0, 0), b2, voffB); PG8_STAGE(PG8_SB(0, 1), b2 + hstep, voffB); PG8_STAGE(PG8_SA(0, 0), a2, voffA);
            PG8_WAIT_V(8); PG8_WAIT_L(0); PG8_BAR; PG8_MMA(1, 0, At, B0); PG8_MMA(1, 1, At, B1); PG8_BAR; PG8_SCHED;
            PG8_LDB(B0, 1, 0); PG8_LDB(B1, 1, 1); PG8_SCHED; PG8_LDA(At, 1, 0); PG8_STAGE(PG8_SA(0, 1), a2 + hstep, voffA);
            PG8_WAIT_V(8); PG8_WAIT_L(0); PG8_BAR; PG8_MMA(0, 0, At, B0); PG8_MMA(0, 1, At, B1); PG8_BAR; PG8_SCHED;
            PG8_LDA(At, 1, 1); PG8_STAGE(PG8_SB(1, 0), b3, voffB); PG8_STAGE(PG8_SB(1, 1), b3 + hstep, voffB); PG8_STAGE(PG8_SA(1, 0), a3, voffA);
            PG8_WAIT_V(8); PG8_WAIT_L(0); PG8_BAR; PG8_MMA(1, 0, At, B0); PG8_MMA(1, 1, At, B1); PG8_BAR; PG8_SCHED;
            } else {
            PG8_LDB(B0, 0, 0); PG8_SCHED; PG8_LDA(At, 0, 0); PG8_STAGE(PG8_SA(1, 1), a1 + hstep, voffA);
            PG8_WAIT_L(8); PG8_BAR; PG8_WAIT_L(0); PG8_MMA(0, 0, At, B0); PG8_BAR; PG8_SCHED;
            PG8_LDB(B1, 0, 1); PG8_STAGE(PG8_SB(0, 0), b2, voffB);
            PG8_BAR; PG8_WAIT_L(0); PG8_MMA(0, 1, At, B1); PG8_BAR;
            PG8_LDA(At, 0, 1); PG8_STAGE(PG8_SA(0, 0), a2, voffA);
            PG8_BAR; PG8_WAIT_L(0); PG8_MMA(1, 0, At, B0); PG8_BAR; PG8_SCHED;
            PG8_STAGE(PG8_SB(0, 1), b2 + hstep, voffB);
            PG8_WAIT_V(6); PG8_BAR; PG8_MMA(1, 1, At, B1); PG8_BAR;
            PG8_LDB(B0, 1, 0); PG8_SCHED; PG8_LDA(At, 1, 0); PG8_STAGE(PG8_SA(0, 1), a2 + hstep, voffA);
            PG8_WAIT_L(8); PG8_BAR; PG8_WAIT_L(0); PG8_MMA(0, 0, At, B0); PG8_BAR; PG8_SCHED;
            PG8_LDB(B1, 1, 1); PG8_STAGE(PG8_SB(1, 0), b3, voffB);
            PG8_BAR; PG8_WAIT_L(0); PG8_MMA(0, 1, At, B1); PG8_BAR;
            PG8_LDA(At, 1, 1); PG8_STAGE(PG8_SA(1, 0), a3, voffA);
            PG8_BAR; PG8_WAIT_L(0); PG8_MMA(1, 0, At, B0); PG8_BAR; PG8_SCHED;
            PG8_STAGE(PG8_SB(1, 1), b3 + hstep, voffB);
            PG8_WAIT_V(6); PG8_BAR; PG8_MMA(1, 1, At, B1); PG8_BAR;
            }
        }
        if constexpr (ALIGN_EPI) { if (wr == 0) PG8_BAR; }
        if constexpr (!Epi::AFTER_DRAIN) { E(acc, rs8, cur, wr, wc, fr, fq, !has_next); S.done(cur); }
        if (has_next && E.rs_src()) { f32x4 rawn[2][4]; rs8_issue(rawn, E.rs_src(), nxt.pm * BM + wr * 64 + fr, fq); rs8_finish(rs8, rawn); }
        if (!has_next) break;
        E.init(acc, nxt, wr, wc, fr, fq);
        cur = nxt; cA = nA; cB = nB; ++ui;
        if constexpr (ALIGN_EPI) { if (wr == 1) PG8_BAR; }
    }
    PG8_WAIT_V(0);
    if constexpr (!ALIGN_EPI) { if (wr == 0) PG8_BAR; }
    PG8_BAR;
    if constexpr (Epi::AFTER_DRAIN) { E.fused(acc, cur, wr, wc, fr, fq, lds, wid, lane); S.done(cur); }
#undef PG8_SA
#undef PG8_SB
#undef PG8_STAGE
#undef PG8_LDA
#undef PG8_LDB
#undef PG8_MMA
#undef PG8_WAIT_V
#undef PG8_WAIT_L
#undef PG8_BAR
#undef PG8_SCHED
}
}

namespace pg8 {
constexpr float kEps = 1e-6f;
constexpr float kLog2e = 1.4426950408889634f;
constexpr float kC2 = 0.125f * 1.4426950408889634f;
__device__ __forceinline__ float rsq_f(float v) { return __builtin_amdgcn_rsqf(v); }
__device__ __forceinline__ float row_rs(const float* ssq, int row, int fq) {
    const f32x4 v = *(const f32x4*)(ssq + (size_t)row * 16 + 4 * fq);
    float s = (v[0] + v[1]) + (v[2] + v[3]);
    s += __shfl_xor(s, 16); s += __shfl_xor(s, 32);
    return rsq_f(s * (1.0f / 1024.0f) + kEps);
}
__device__ __forceinline__ void acc_zero(f32x4 (&acc)[2][2][4][2]) {
#pragma unroll
    for (int a = 0; a < 2; ++a)
#pragma unroll
        for (int b = 0; b < 2; ++b)
#pragma unroll
            for (int m = 0; m < 4; ++m)
#pragma unroll
                for (int n = 0; n < 2; ++n) acc[a][b][m][n] = (f32x4){0.f, 0.f, 0.f, 0.f};
}
__device__ __forceinline__ void row_rs8(float (&rs)[2][4], const float* ssq, int row0, int fq) {
    f32x4 v[2][4];
#pragma unroll
    for (int ai = 0; ai < 2; ++ai)
#pragma unroll
        for (int m = 0; m < 4; ++m) v[ai][m] = *(const f32x4*)(ssq + (size_t)(row0 + ai * HALF + m * 16) * 16 + 4 * fq);
#pragma unroll
    for (int ai = 0; ai < 2; ++ai)
#pragma unroll
        for (int m = 0; m < 4; ++m) { float s = (v[ai][m][0] + v[ai][m][1]) + (v[ai][m][2] + v[ai][m][3]); s += __shfl_xor(s, 16); s += __shfl_xor(s, 32); rs[ai][m] = rsq_f(s * (1.0f / 1024.0f) + kEps); }
}
__device__ __forceinline__ void st16(void* p, u32x4 v) { asm volatile("global_store_dwordx4 %0, %1, off\n\ts_nop 1" : : "v"(p), "v"(v) : "memory"); }
__device__ __forceinline__ void st16_wt(void* p, u32x4 v) { asm volatile("global_store_dwordx4 %0, %1, off sc1\n\ts_nop 1" : : "v"(p), "v"(v) : "memory"); }
__device__ __forceinline__ void st8_wt(void* p, u32x2 v) { asm volatile("global_store_dwordx2 %0, %1, off sc1\n\ts_nop 1" : : "v"(p), "v"(v) : "memory"); }
__device__ __forceinline__ void st16f(void* p, f32x4 v) { asm volatile("global_store_dwordx4 %0, %1, off\n\ts_nop 1" : : "v"(p), "v"(v) : "memory"); }
__device__ __forceinline__ float sigmoid_f(float y) { return __builtin_amdgcn_rcpf(1.0f + __builtin_amdgcn_exp2f(-kLog2e * y)); }
__device__ __forceinline__ float gelu_tanh_f(float x) {
    const float t = x * (1.0f + 0.044715f * x * x);
    return x * __builtin_amdgcn_rcpf(1.0f + __builtin_amdgcn_exp2f(-2.302208198f * t));
}
__device__ __forceinline__ float bf_lo(unsigned w) { return __uint_as_float(w << 16); }
__device__ __forceinline__ float bf_hi(unsigned w) { return __uint_as_float(w & 0xffff0000u); }

struct EpiAct {
    static constexpr bool PERM = true, AFTER_DRAIN = false;
    bf16_t* O; int ldc; const float* ssq_in; float* ssq_out; int act;
    __device__ __forceinline__ void init(f32x4 (&acc)[2][2][4][2], const Unit&, int, int, int, int) const { acc_zero(acc); }
    __device__ __forceinline__ const float* rs_src() const { return ssq_in; }
    __device__ __forceinline__ void operator()(const f32x4 (&acc)[2][2][4][2], const float (&rsa)[2][4], const Unit& u, int wr, int wc, int fr, int fq, bool wt) const {
        const int row0 = u.pm * BM + wr * 64 + fr, col0 = u.pn * BM + wc * 32 + 8 * fq;
        const bool want = (act == 1) && (u.pn >= 4);
#pragma unroll
        for (int ai = 0; ai < 2; ++ai)
#pragma unroll
            for (int m = 0; m < 4; ++m) {
                const int row = row0 + ai * HALF + m * 16;
                const float rs = ssq_in ? rsa[ai][m] : 1.0f;
                float q = 0.f;
#pragma unroll
                for (int bj = 0; bj < 2; ++bj) {
                    f32x4 v0 = acc[ai][bj][m][0] * rs, v1 = acc[ai][bj][m][1] * rs;
                    if (act == 1) {
#pragma unroll
                        for (int j = 0; j < 4; ++j) { v0[j] = gelu_tanh_f(v0[j]); v1[j] = gelu_tanh_f(v1[j]); }
                    } else if (act == 2) {
#pragma unroll
                        for (int j = 0; j < 4; ++j) { const float a = fmaxf(v0[j], 0.f), b = fmaxf(v1[j], 0.f); v0[j] = a * a; v1[j] = b * b; }
                    }
                    if (want) q += (v0[0] * v0[0] + v0[1] * v0[1]) + (v0[2] * v0[2] + v0[3] * v0[3]) + (v1[0] * v1[0] + v1[1] * v1[1]) + (v1[2] * v1[2] + v1[3] * v1[3]);
                    u32x4 w; w.x = cvt_pk_bf16(v0[0], v0[1]); w.y = cvt_pk_bf16(v0[2], v0[3]); w.z = cvt_pk_bf16(v1[0], v1[1]); w.w = cvt_pk_bf16(v1[2], v1[3]);
                    if (wt) st16_wt(O + (size_t)row * ldc + col0 + bj * HALF, w); else if (act == 2) __builtin_nontemporal_store(w, (u32x4*)(O + (size_t)row * ldc + col0 + bj * HALF)); else *(u32x4*)(O + (size_t)row * ldc + col0 + bj * HALF) = w;
                }
                if (want) { q += __shfl_xor(q, 16); q += __shfl_xor(q, 32); if (fq == 0) ssq_out[(size_t)row * 16 + (u.pn - 4) * 4 + wc] = q; }
            }
    }
};

template <bool FINAL> struct EpiResT {
    static constexpr bool PERM = true, AFTER_DRAIN = false;
    const bf16_t* xr; bf16_t* xb; float* xout; float* ssq_out; const float* ssq_in; const bf16_t* pp; int gate;
    __device__ __forceinline__ void init(f32x4 (&acc)[2][2][4][2], const Unit& u, int wr, int wc, int fr, int fq) const {
        if (gate) { acc_zero(acc); return; }
        const int row0 = u.pm * BM + wr * 64 + fr, col0 = u.pn * BM + wc * 32 + 8 * fq;
        u32x4 w[2][4][2];
#pragma unroll
        for (int ai = 0; ai < 2; ++ai)
#pragma unroll
            for (int m = 0; m < 4; ++m)
#pragma unroll
                for (int bj = 0; bj < 2; ++bj) w[ai][m][bj] = *(const u32x4*)(xr + (size_t)(row0 + ai * HALF + m * 16) * 1024 + col0 + bj * HALF);
#pragma unroll
        for (int ai = 0; ai < 2; ++ai)
#pragma unroll
            for (int m = 0; m < 4; ++m)
#pragma unroll
                for (int bj = 0; bj < 2; ++bj) { const u32x4 t = w[ai][m][bj];
                    acc[ai][bj][m][0] = (f32x4){bf_lo(t.x), bf_hi(t.x), bf_lo(t.y), bf_hi(t.y)}; acc[ai][bj][m][1] = (f32x4){bf_lo(t.z), bf_hi(t.z), bf_lo(t.w), bf_hi(t.w)}; }
    }
    __device__ __forceinline__ const float* rs_src() const { return gate ? ssq_in : nullptr; }
    __device__ __forceinline__ void operator()(const f32x4 (&acc)[2][2][4][2], const float (&rsa)[2][4], const Unit& u, int wr, int wc, int fr, int fq, bool wt) const {
        const int row0 = u.pm * BM + wr * 64 + fr, col0 = u.pn * BM + wc * 32 + 8 * fq;
        u32x4 xa[2], pa[2];
        if (gate) {
#pragma unroll
            for (int bj = 0; bj < 2; ++bj) { const size_t off = (size_t)row0 * 1024 + col0 + bj * HALF; xa[bj] = *(const u32x4*)(xr + off); pa[bj] = *(const u32x4*)(pp + off); }
        }
#pragma unroll
        for (int ai = 0; ai < 2; ++ai)
#pragma unroll
            for (int m = 0; m < 4; ++m) {
                const int row = row0 + ai * HALF + m * 16;
                u32x4 xc[2], pc[2];
                if (gate) {
#pragma unroll
                    for (int bj = 0; bj < 2; ++bj) { xc[bj] = xa[bj]; pc[bj] = pa[bj]; }
                    if (ai * 4 + m < 7) { const int nrow = row0 + ((ai * 4 + m + 1) >> 2) * HALF + ((ai * 4 + m + 1) & 3) * 16;
#pragma unroll
                        for (int bj = 0; bj < 2; ++bj) { const size_t off = (size_t)nrow * 1024 + col0 + bj * HALF; xa[bj] = *(const u32x4*)(xr + off); pa[bj] = *(const u32x4*)(pp + off); } }
                }
                float q = 0.f;
#pragma unroll
                for (int bj = 0; bj < 2; ++bj) {
                    const size_t off = (size_t)row * 1024 + col0 + bj * HALF;
                    f32x4 v0 = acc[ai][bj][m][0], v1 = acc[ai][bj][m][1];
                    if (gate) {
                        const float rs = rsa[ai][m]; const u32x4 pw = pc[bj], xw = xc[bj];
                        v0[0] = bf_lo(xw.x) + bf_lo(pw.x) * sigmoid_f(rs * v0[0]); v0[1] = bf_hi(xw.x) + bf_hi(pw.x) * sigmoid_f(rs * v0[1]);
                        v0[2] = bf_lo(xw.y) + bf_lo(pw.y) * sigmoid_f(rs * v0[2]); v0[3] = bf_hi(xw.y) + bf_hi(pw.y) * sigmoid_f(rs * v0[3]);
                        v1[0] = bf_lo(xw.z) + bf_lo(pw.z) * sigmoid_f(rs * v1[0]); v1[1] = bf_hi(xw.z) + bf_hi(pw.z) * sigmoid_f(rs * v1[1]);
                        v1[2] = bf_lo(xw.w) + bf_lo(pw.w) * sigmoid_f(rs * v1[2]); v1[3] = bf_hi(xw.w) + bf_hi(pw.w) * sigmoid_f(rs * v1[3]);
                    }
                    if constexpr (FINAL) { *(f32x4*)(xout + off) = v0; *(f32x4*)(xout + off + 4) = v1; }
                    else {
                        q += (v0[0] * v0[0] + v0[1] * v0[1]) + (v0[2] * v0[2] + v0[3] * v0[3]) + (v1[0] * v1[0] + v1[1] * v1[1]) + (v1[2] * v1[2] + v1[3] * v1[3]);
                        u32x4 w; w.x = cvt_pk_bf16(v0[0], v0[1]); w.y = cvt_pk_bf16(v0[2], v0[3]); w.z = cvt_pk_bf16(v1[0], v1[1]); w.w = cvt_pk_bf16(v1[2], v1[3]);
                        if (wt) st16_wt(xb + off, w); else *(u32x4*)(xb + off) = w;
                    }
                }
                if constexpr (!FINAL) { q += __shfl_xor(q, 16); q += __shfl_xor(q, 32); if (fq == 0) ssq_out[(size_t)row * 16 + u.pn * 4 + wc] = q; }
            }
    }
};

struct EpiQKV {
    static constexpr bool PERM = true, AFTER_DRAIN = false;
    bf16_t* QKV; size_t tstride; const float* ssq_in; const float* gq; const float* gk;
    __device__ __forceinline__ void init(f32x4 (&acc)[2][2][4][2], const Unit&, int, int, int, int) const { acc_zero(acc); }
    __device__ __forceinline__ const float* rs_src() const { return ssq_in; }
    __device__ __forceinline__ void operator()(const f32x4 (&acc)[2][2][4][2], const float (&rsa)[2][4], const Unit& u, int wr, int wc, int fr, int fq, bool wt) const {
        const int row0 = u.pm * BM + wr * 64 + fr; const int t = u.pn >> 2;
        bf16_t* base = QKV + (size_t)t * tstride; const int colb = (u.pn & 3) * BM + 64 * wc + 8 * fq;
        const float* gp = (t == 0) ? gq : gk; const float sc = (t == 0) ? kC2 : 1.0f;
        f32x4 gg[2][2];
#pragma unroll
        for (int bj = 0; bj < 2; ++bj) { gg[bj][0] = (f32x4){1.f, 1.f, 1.f, 1.f}; gg[bj][1] = gg[bj][0]; if (t < 2) { gg[bj][0] = *(const f32x4*)(gp + 32 * bj + 8 * fq); gg[bj][1] = *(const f32x4*)(gp + 32 * bj + 8 * fq + 4); } }
#pragma unroll
        for (int ai = 0; ai < 2; ++ai)
#pragma unroll
            for (int m = 0; m < 4; ++m) {
                const int row = row0 + ai * HALF + m * 16;
                const float rs = rsa[ai][m];
                float q = 0.f;
#pragma unroll
                for (int bj = 0; bj < 2; ++bj)
#pragma unroll
                    for (int n = 0; n < 2; ++n) { const f32x4 a = acc[ai][bj][m][n]; q += (a[0] * a[0] + a[1] * a[1]) + (a[2] * a[2] + a[3] * a[3]); }
                q *= rs * rs;
                q += __shfl_xor(q, 16); q += __shfl_xor(q, 32);
                const float hn = ((t < 2) ? rsq_f(q * (1.0f / 64.0f) + kEps) * sc : 1.0f) * rs;
#pragma unroll
                for (int bj = 0; bj < 2; ++bj) {
                    const f32x4 v0 = acc[ai][bj][m][0] * hn * gg[bj][0], v1 = acc[ai][bj][m][1] * hn * gg[bj][1];
                    u32x4 w; w.x = cvt_pk_bf16(v0[0], v0[1]); w.y = cvt_pk_bf16(v0[2], v0[3]); w.z = cvt_pk_bf16(v1[0], v1[1]); w.w = cvt_pk_bf16(v1[2], v1[3]);
                    if (wt) st16_wt(base + (size_t)row * 1024 + colb + 32 * bj, w); else st16(base + (size_t)row * 1024 + colb + 32 * bj, w);
                }
            }
    }
};
}

#define LAS __attribute__((address_space(3)))
typedef unsigned short bf16;
typedef unsigned v4u __attribute__((ext_vector_type(4)));
typedef unsigned v2u __attribute__((ext_vector_type(2)));
typedef float f32x4 __attribute__((ext_vector_type(4)));
typedef float f32x16 __attribute__((ext_vector_type(16)));
typedef short bf16x8 __attribute__((ext_vector_type(8)));
typedef short s16x4 __attribute__((ext_vector_type(4)));
typedef _Float16 f16x8 __attribute__((ext_vector_type(8)));

#ifndef MK_SINGLE
#define MK_SINGLE 1
#endif

constexpr int NWAVES = 8;
constexpr int BATCH = 8, SEQ = 2048, D = 1024, H = 16, HD = 64, FF = 4096, PLE = 256, CHUNK = 128, NGRP = 8;
constexpr int M = BATCH * SEQ;
constexpr size_t MiB = 1u << 20;
constexpr size_t WS_CTL = 0;
constexpr size_t WS_SSQ = 1 * MiB;
constexpr size_t WS_WIN = 9 * MiB, WS_WOA = 13 * MiB, WS_WQKV = 15 * MiB, WS_WOB = 21 * MiB, WS_WUP = 23 * MiB, WS_WDN = 39 * MiB, WS_WG = 55 * MiB, WS_WPP = 59 * MiB;
constexpr size_t WS_PBF = 60 * MiB;
constexpr size_t WS_XB = 76 * MiB;
constexpr size_t WS_BIG = 108 * MiB;
constexpr size_t WS_END = 236 * MiB;
constexpr int LDS_BYTES = 147456;
enum { SQ_X0 = 0, SQ_V = 1, SQ_X1 = 2, SQ_X2 = 3, SQ_X3 = 4, SQ_X4 = 5, SQ_X5 = 6, SQ_X6 = 7 };

struct Args {
    const float* in[21];
    float* out; unsigned char* ws; int lo, hi;
};

struct Frame {
    LAS unsigned char* lds; int vcu, G;
};

__device__ __forceinline__ unsigned f2bf(float f) { unsigned u = __builtin_bit_cast(unsigned, f); return (u + 0x7fffu + ((u >> 16) & 1u)) >> 16; }
__device__ __forceinline__ unsigned pk2(float lo, float hi) { return f2bf(lo) | (f2bf(hi) << 16); }
__device__ __forceinline__ float wave_sum(float v) {
#pragma unroll
    for (int o = 1; o < 64; o <<= 1) v += __shfl_xor(v, o);
    return v;
}

__device__ __forceinline__ void tr_item(const float* W, int K, int N, const float* gain, bf16* WT, int row_off, bool headperm, LAS float* scr, int item, int lane) {
    const int nblk = N / 32, kb = item / nblk, nb = item % nblk, k0 = 64 * kb, n0 = 32 * nb;
    f32x4 w[8];
#pragma unroll
    for (int i = 0; i < 8; ++i) { const int idx = i * 64 + lane, kk = idx >> 3, n4 = idx & 7; w[i] = __builtin_nontemporal_load((const f32x4*)(W + (size_t)(k0 + kk) * N + n0 + 4 * n4)); }
    if (gain) {
#pragma unroll
        for (int i = 0; i < 8; ++i) { const int kk = (i * 64 + lane) >> 3; w[i] = w[i] * gain[k0 + kk]; }
    }
#pragma unroll
    for (int i = 0; i < 8; ++i) { const int idx = i * 64 + lane, kk = idx >> 3, n4 = idx & 7; LAS float* d = scr + kk * 33 + 4 * n4; d[0] = w[i][0]; d[1] = w[i][1]; d[2] = w[i][2]; d[3] = w[i][3]; }
    asm volatile("s_waitcnt lgkmcnt(0)" ::: "memory");
    int d0 = n0;
    if (headperm) { const int ja = n0 & 255, wc = ja >> 6, bj = (ja >> 5) & 1; d0 = (n0 - ja) + 128 * bj + 32 * wc; }
    const int c = lane & 7;
#pragma unroll
    for (int j = 0; j < 4; ++j) { const int n = (lane >> 3) + 8 * j; const LAS float* s = scr + (8 * c) * 33 + n;
        v4u o; o.x = pk2(s[0 * 33], s[1 * 33]); o.y = pk2(s[2 * 33], s[3 * 33]); o.z = pk2(s[4 * 33], s[5 * 33]); o.w = pk2(s[6 * 33], s[7 * 33]);
        *(v4u*)(WT + (size_t)(row_off + d0 + n) * K + k0 + 8 * c) = o; }
    asm volatile("s_waitcnt lgkmcnt(0)" ::: "memory");
}

__device__ __forceinline__ const float* pick_in(const Args& a, int i) {
    const float* p = a.in[2];
    switch (i) { case 3: p = a.in[3]; break; case 7: p = a.in[7]; break; case 8: p = a.in[8]; break; case 9: p = a.in[9]; break; case 11: p = a.in[11]; break; case 12: p = a.in[12]; break;
                 case 14: p = a.in[14]; break; case 15: p = a.in[15]; break; case 16: p = a.in[16]; break; case 17: p = a.in[17]; break; case 18: p = a.in[18]; break; case 19: p = a.in[19]; break; case 20: p = a.in[20]; break; default: break; }
    return p;
}
__device__ __forceinline__ void prologue_phase(const Frame& F, const Args& a) {
    unsigned char* ws = a.ws;
    int tid_ = threadIdx.x; asm volatile("" : "+v"(tid_));
    const int lane_ = tid_ & 63, wave_ = __builtin_amdgcn_readfirstlane(tid_ >> 6);
    LAS float* scr = (LAS float*)(F.lds + wave_ * 16384);
    const int gw = F.vcu * NWAVES + wave_, NGW = F.G * NWAVES;
    constexpr int I_IN = (D / 64) * (2 * D / 32), I_SQ = (D / 64) * (D / 32), I_KV = I_IN, I_UP = (D / 64) * (FF / 32), I_DN = (FF / 64) * (D / 32), I_PP = (PLE / 64) * (D / 32);
    constexpr int NITEMS = I_IN + I_SQ + I_SQ + I_KV + I_SQ + 2 * I_UP + 2 * I_DN + 2 * I_SQ + 2 * I_PP;
    for (int i = 4 * gw; i < (2 * M * PLE) / 512; i += 4 * NGW) {
        const f32x4* pr = (const f32x4*)(a.in[1] + (size_t)i * 512) + 2 * lane_;
        f32x4 x[8];
#pragma unroll
        for (int j = 0; j < 4; ++j) { x[2 * j] = __builtin_nontemporal_load(pr + 128 * j); x[2 * j + 1] = __builtin_nontemporal_load(pr + 128 * j + 1); }
#pragma unroll
        for (int j = 0; j < 4; ++j) { v4u o; o.x = pk2(x[2 * j].x, x[2 * j].y); o.y = pk2(x[2 * j].z, x[2 * j].w); o.z = pk2(x[2 * j + 1].x, x[2 * j + 1].y); o.w = pk2(x[2 * j + 1].z, x[2 * j + 1].w);
            *((v4u*)((bf16*)(ws + WS_PBF) + (size_t)(i + j) * 512) + lane_) = o; }
    }
    for (int it = gw; it < NITEMS; it += NGW) {
        int r = NITEMS - 1 - it, ii = 3, ig = 2, K = D, N = 2 * D, roff = 0; size_t woff = 0, dsto = WS_WIN; int goff = 0; bool hp = false, done = false;
        if (r < I_IN) { done = true; } else r -= I_IN;
        if (!done) { if (r < I_SQ) { ii = 7; ig = -1; N = D; dsto = WS_WOA; done = true; } else r -= I_SQ; }
        if (!done) { if (r < I_SQ) { ii = 12; ig = 11; N = D; dsto = WS_WQKV; hp = true; done = true; } else r -= I_SQ; }
        if (!done) { if (r < I_KV) { ii = 9; ig = 8; N = 2 * D; dsto = WS_WQKV; roff = D; hp = true; done = true; } else r -= I_KV; }
        if (!done) { if (r < I_SQ) { ii = 14; ig = -1; N = D; dsto = WS_WOB; done = true; } else r -= I_SQ; }
        if (!done) { if (r < 2 * I_UP) { const int l = r / I_UP; r -= l * I_UP; ii = 16; ig = 15; N = FF; woff = (size_t)l * D * FF; goff = l * D; dsto = WS_WUP + woff * 2; done = true; } else r -= 2 * I_UP; }
        if (!done) { if (r < 2 * I_DN) { const int l = r / I_DN; r -= l * I_DN; ii = 17; ig = -1; K = FF; N = D; woff = (size_t)l * D * FF; dsto = WS_WDN + woff * 2; done = true; } else r -= 2 * I_DN; }
        if (!done) { if (r < 2 * I_SQ) { const int l = r / I_SQ; r -= l * I_SQ; ii = 19; ig = 18; N = D; woff = (size_t)l * D * D; goff = l * D; dsto = WS_WG + woff * 2; done = true; } else r -= 2 * I_SQ; }
        if (!done) { const int l = r / I_PP; r -= l * I_PP; ii = 20; ig = -1; K = PLE; N = D; woff = (size_t)l * PLE * D; dsto = WS_WPP + woff * 2; }
        const float* Wp = pick_in(a, ii) + woff; const float* gp = (ig >= 0) ? pick_in(a, ig) + goff : nullptr;
        tr_item(Wp, K, N, gp, (bf16*)(ws + dsto), roff, hp, scr, r, lane_);
    }
    float* ssq0 = (float*)(ws + WS_SSQ) + (size_t)SQ_X0 * M * 16;
    for (int m = 2 * gw; m < M; m += 2 * NGW) {
        const f32x4* xr = (const f32x4*)(a.in[0] + (size_t)m * D) + lane_;
        f32x4 v[8]; float s0 = 0.f, s1 = 0.f;
#pragma unroll
        for (int j = 0; j < 8; ++j) v[j] = __builtin_nontemporal_load(xr + 64 * j);
#pragma unroll
        for (int j = 0; j < 4; ++j) { s0 += (v[j].x * v[j].x + v[j].y * v[j].y) + (v[j].z * v[j].z + v[j].w * v[j].w); s1 += (v[4 + j].x * v[4 + j].x + v[4 + j].y * v[4 + j].y) + (v[4 + j].z * v[4 + j].z + v[4 + j].w * v[4 + j].w); }
        s0 = wave_sum(s0); s1 = wave_sum(s1);
        unsigned long long* o8 = (unsigned long long*)((bf16*)(ws + WS_XB) + (size_t)m * D) + lane_;
#pragma unroll
        for (int j = 0; j < 8; ++j) o8[64 * j] = (unsigned long long)pk2(v[j].x, v[j].y) | ((unsigned long long)pk2(v[j].z, v[j].w) << 32);
        if (lane_ < 32) ssq0[(size_t)m * 16 + lane_] = (lane_ == 0) ? s0 : (lane_ == 16) ? s1 : 0.f;
    }
}

__device__ __forceinline__ void sgu_phase(const Frame& F, const Args& a) {
    unsigned char* ws = a.ws;
    const bf16* Z = (const bf16*)(ws + WS_BIG); bf16* Y = (bf16*)(ws + WS_BIG + 64 * MiB);
    const float* ssqv = (const float*)(ws + WS_SSQ) + (size_t)SQ_V * M * 16;
    const float* wsp = a.in[5]; const float* bsp = a.in[6]; const float* gv = a.in[4];
    constexpr int RS = 272;
    LAS unsigned char* WSL = F.lds; LAS unsigned char* VTL = F.lds + 128 * RS; LAS float* rsl = (LAS float*)(F.lds + 2 * 128 * RS);
    int tid_ = threadIdx.x; asm volatile("" : "+v"(tid_));
    const int tid = tid_, lane = tid & 63, w = __builtin_amdgcn_readfirstlane(tid >> 6), fr = lane & 15, fq = lane >> 4;
    for (int unit = F.vcu; unit < (M / CHUNK) * NGRP; unit += F.G) {
        const int c = unit >> 3, g = unit & 7, rowb = c * CHUNK;
        if (tid < 128) { const f32x4* sp = (const f32x4*)(ssqv + (size_t)(rowb + tid) * 16); const f32x4 s0 = sp[0], s1 = sp[1], s2 = sp[2], s3 = sp[3];
            const float s = ((s0[0] + s0[1]) + (s0[2] + s0[3])) + ((s1[0] + s1[1]) + (s1[2] + s1[3])) + ((s2[0] + s2[1]) + (s2[2] + s2[3])) + ((s3[0] + s3[1]) + (s3[2] + s3[3]));
            rsl[tid] = __builtin_amdgcn_rsqf(s * (1.0f / 1024.0f) + 1e-6f); }
        __syncthreads();
#pragma unroll
        for (int i = 0; i < 8; ++i) { const int idx = i * 512 + tid, t = idx >> 5, s4 = idx & 31;
            const f32x4 wv = *(const f32x4*)(wsp + (size_t)g * 16384 + t * 128 + 4 * s4); const f32x4 r = *(const LAS f32x4*)(rsl + 4 * s4);
            float e[4];
#pragma unroll
            for (int k = 0; k < 4; ++k) e[k] = (4 * s4 + k <= t) ? wv[k] * r[k] : 0.f;
            v2u o; o.x = pk2(e[0], e[1]); o.y = pk2(e[2], e[3]);
            *(LAS v2u*)(WSL + t * RS + s4 * 8) = o; }
#pragma unroll
        for (int i = 0; i < 4; ++i) { const int idx = i * 512 + tid, dc = idx >> 7, s = idx & 127;
            const v4u pv = *(const v4u*)(Z + (size_t)(rowb + s) * 2048 + 1024 + g * 128 + dc * 8);
#pragma unroll
            for (int j = 0; j < 8; ++j) { const unsigned hw = (pv[j >> 1] >> (16 * (j & 1))) & 0xffffu; *(LAS unsigned short*)(VTL + (dc * 8 + j) * RS + s * 2) = (unsigned short)hw; } }
        __syncthreads();
        const int t0 = 16 * w, nks = (w >> 1) + 1;
        bf16x8 wf[4];
#pragma unroll
        for (int ks = 0; ks < 4; ++ks) wf[ks] = (ks < nks) ? *(const LAS bf16x8*)(WSL + (t0 + fr) * RS + (32 * ks + 8 * fq) * 2) : (bf16x8){0, 0, 0, 0, 0, 0, 0, 0};
        f32x4 acc[8];
#pragma unroll
        for (int n = 0; n < 8; ++n) { acc[n] = (f32x4){0.f, 0.f, 0.f, 0.f};
#pragma unroll
            for (int ks = 0; ks < 4; ++ks) if (ks < nks) { const bf16x8 vf = *(const LAS bf16x8*)(VTL + (16 * n + fr) * RS + (32 * ks + 8 * fq) * 2);
                acc[n] = __builtin_amdgcn_mfma_f32_16x16x32_bf16(vf, wf[ks], acc[n], 0, 0, 0); } }
        const int t = t0 + fr, row = rowb + t; const float bias = bsp[g * 128 + t];
#pragma unroll
        for (int n = 0; n < 8; ++n) { const int col = g * 128 + 16 * n + 4 * fq;
            const f32x4 gg = *(const f32x4*)(gv + col); const v2u uu = *(const v2u*)(Z + (size_t)row * 2048 + col);
            const float y0 = __uint_as_float(uu.x << 16) * (gg[0] * acc[n][0] + bias), y1 = __uint_as_float(uu.x & 0xffff0000u) * (gg[1] * acc[n][1] + bias);
            const float y2 = __uint_as_float(uu.y << 16) * (gg[2] * acc[n][2] + bias), y3 = __uint_as_float(uu.y & 0xffff0000u) * (gg[3] * acc[n][3] + bias);
            v2u o; o.x = pk2(y0, y1); o.y = pk2(y2, y3);
            if (unit + F.G >= (M / CHUNK) * NGRP) pg8::st8_wt(Y + (size_t)row * 1024 + col, o); else *(v2u*)(Y + (size_t)row * 1024 + col) = o; }
        __syncthreads();
    }
}

__device__ __forceinline__ int crow(int r, int hi) { return (r & 3) + 8 * (r >> 2) + 4 * hi; }
__device__ __forceinline__ unsigned cvtpk_s(float lo, float hi) { typedef float f2 __attribute__((ext_vector_type(2))); typedef __bf16 b2 __attribute__((ext_vector_type(2))); f2 v = {lo, hi}; b2 b = __builtin_convertvector(v, b2); return __builtin_bit_cast(unsigned, b); }
__device__ __forceinline__ unsigned cvtpk_h(float lo, float hi) { typedef float f2 __attribute__((ext_vector_type(2))); typedef _Float16 h2 __attribute__((ext_vector_type(2))); f2 v = {lo, hi}; h2 h = __builtin_convertvector(v, h2); return __builtin_bit_cast(unsigned, h); }
constexpr int AT_K = 0, AT_V = 40960, AT_OST = 90112, AT_SLOT = 8192, AT_FLAG = 122880;
constexpr float ATT_CUT = 60.0f;
struct PFrag { bf16x8 a0, a1, a2, a3; };
__device__ __forceinline__ PFrag attn_front(const LAS unsigned char* kb, const bf16x8 (&qr)[4], f32x16& cvn, const f16x8 Ts0, const f16x8 Ts1, const f16x8 ONES, const bool needmask, const int kmin, const int tq, const int hi) {
    f32x16 p0 = f32x16{}, p1 = f32x16{};
#pragma unroll
    for (int d0 = 0; d0 < 4; ++d0) { const bf16x8 b0 = *(const LAS bf16x8*)(kb + d0 * 2048), b1 = *(const LAS bf16x8*)(kb + d0 * 2048 + 512);
        p0 = __builtin_amdgcn_mfma_f32_32x32x16_bf16(b0, qr[d0], p0, 0, 0, 0); p1 = __builtin_amdgcn_mfma_f32_32x32x16_bf16(b1, qr[d0], p1, 0, 0, 0); }
    f32x16 g0, g1;
#pragma unroll
    for (int r = 0; r < 16; ++r) { g0[r] = __builtin_amdgcn_logf(1.0f + __builtin_amdgcn_exp2f(p0[r])); g1[r] = __builtin_amdgcn_logf(1.0f + __builtin_amdgcn_exp2f(p1[r])); }
    if (needmask) {
#pragma unroll
        for (int r = 0; r < 16; ++r) { const int kv = kmin + crow(r, hi); if (kv >= tq) { g0[r] = 0.f; p0[r] = -INFINITY; } if (kv + 32 >= tq) { g1[r] = 0.f; p1[r] = -INFINITY; } }
    }
    unsigned n0[8], n1[8];
#pragma unroll
    for (int i = 0; i < 8; ++i) { n0[i] = cvtpk_h(-g0[2 * i], -g0[2 * i + 1]); n1[i] = cvtpk_h(-g1[2 * i], -g1[2 * i + 1]); }
    const f16x8 nl00 = __builtin_bit_cast(f16x8, (v4u){n0[0], n0[1], n0[2], n0[3]}), nl01 = __builtin_bit_cast(f16x8, (v4u){n0[4], n0[5], n0[6], n0[7]});
    const f16x8 nl10 = __builtin_bit_cast(f16x8, (v4u){n1[0], n1[1], n1[2], n1[3]}), nl11 = __builtin_bit_cast(f16x8, (v4u){n1[4], n1[5], n1[6], n1[7]});
    f32x16 U = __builtin_amdgcn_mfma_f32_32x32x16_f16(ONES, nl10, cvn, 0, 0, 0); U = __builtin_amdgcn_mfma_f32_32x32x16_f16(ONES, nl11, U, 0, 0, 0);
    f32x16 X1 = p1 + cvn;
    X1 = __builtin_amdgcn_mfma_f32_32x32x16_f16(Ts0, nl10, X1, 0, 0, 0); X1 = __builtin_amdgcn_mfma_f32_32x32x16_f16(Ts1, nl11, X1, 0, 0, 0);
    f32x16 X0 = p0 + U;
    X0 = __builtin_amdgcn_mfma_f32_32x32x16_f16(Ts0, nl00, X0, 0, 0, 0); X0 = __builtin_amdgcn_mfma_f32_32x32x16_f16(Ts1, nl01, X0, 0, 0, 0);
    cvn = __builtin_amdgcn_mfma_f32_32x32x16_f16(ONES, nl00, U, 0, 0, 0); cvn = __builtin_amdgcn_mfma_f32_32x32x16_f16(ONES, nl01, cvn, 0, 0, 0);
    unsigned pw[16];
#pragma unroll
    for (int i = 0; i < 8; ++i) { pw[i] = cvtpk_s(__builtin_amdgcn_exp2f(X0[2 * i]), __builtin_amdgcn_exp2f(X0[2 * i + 1])); pw[8 + i] = cvtpk_s(__builtin_amdgcn_exp2f(X1[2 * i]), __builtin_amdgcn_exp2f(X1[2 * i + 1])); }
    PFrag P;
    P.a0 = __builtin_bit_cast(bf16x8, (v4u){pw[0], pw[1], pw[2], pw[3]}); P.a1 = __builtin_bit_cast(bf16x8, (v4u){pw[4], pw[5], pw[6], pw[7]});
    P.a2 = __builtin_bit_cast(bf16x8, (v4u){pw[8], pw[9], pw[10], pw[11]}); P.a3 = __builtin_bit_cast(bf16x8, (v4u){pw[12], pw[13], pw[14], pw[15]});
    return P;
}
__device__ __forceinline__ void attn_pv(f32x16 (&o)[2], const int vb, const PFrag& P) {
#pragma unroll
    for (int d0 = 0; d0 < 2; ++d0) { s16x4 lo4[4], hi4[4];
#pragma unroll
        for (int ks = 0; ks < 4; ++ks) {
            asm volatile("ds_read_b64_tr_b16 %0,%1 offset:%c2" : "=&v"(lo4[ks]) : "v"(vb), "i"(d0 * 4096 + ks * 1024) : "memory");
            asm volatile("ds_read_b64_tr_b16 %0,%1 offset:%c2" : "=&v"(hi4[ks]) : "v"(vb), "i"(d0 * 4096 + ks * 1024 + 512) : "memory"); }
        asm volatile("s_waitcnt lgkmcnt(0)" ::: "memory"); __builtin_amdgcn_sched_barrier(0);
#define PKV(k) (bf16x8){lo4[k][0], lo4[k][1], lo4[k][2], lo4[k][3], hi4[k][0], hi4[k][1], hi4[k][2], hi4[k][3]}
        o[d0] = __builtin_amdgcn_mfma_f32_32x32x16_bf16(P.a0, PKV(0), o[d0], 0, 0, 0);
        o[d0] = __builtin_amdgcn_mfma_f32_32x32x16_bf16(P.a1, PKV(1), o[d0], 0, 0, 0);
        o[d0] = __builtin_amdgcn_mfma_f32_32x32x16_bf16(P.a2, PKV(2), o[d0], 0, 0, 0);
        o[d0] = __builtin_amdgcn_mfma_f32_32x32x16_bf16(P.a3, PKV(3), o[d0], 0, 0, 0);
#undef PKV
    }
}

__device__ __forceinline__ void attn_unit(int b, int h, int qb, const bf16* Q, const bf16* K, const bf16* V, bf16* O, LAS unsigned char* lds, bool wt) {
    int tid_ = threadIdx.x; asm volatile("" : "+v"(tid_));
    const int tid = tid_, lane = tid & 63, r32 = lane & 31, hi = lane >> 5; const int wid = __builtin_amdgcn_readfirstlane(tid >> 6);
    const long rowbase = (long)b * SEQ; const int q0 = qb * 256;
    const bf16* Qw = Q + (rowbase + q0 + wid * 32) * D + h * HD;
    const bf16* ksrc = K + (rowbase + lane) * D + h * HD + wid * 8;
    const bf16* vsrc = V + (rowbase + 16 * (wid & 3) + (lane >> 2)) * D + h * HD + (wid >> 2) * 32 + (lane & 3) * 8;
    const int sdst = wid * 1024 + lane * 16;
    const unsigned lds0 = (unsigned)(uintptr_t)lds;
    const int vb0 = (int)(lds0 + AT_V) + ((lane >> 4) & 1) * 32 + (lane & 3) * 8 + (4 * hi + ((lane & 15) >> 2)) * 64;
    const LAS unsigned char* kb0 = lds + AT_K + hi * 1024 + r32 * 16;
    bf16x8 qr[4];
#pragma unroll
    for (int d0 = 0; d0 < 4; ++d0) qr[d0] = *(const bf16x8*)(Qw + (long)r32 * D + d0 * 16 + hi * 8);
    const int NT = 4 * (qb + 1);
    f32x16 o[2]; o[0] = f32x16{}; o[1] = f32x16{};
    f32x16 cvn = f32x16{};
    f16x8 Ts0, Ts1, ONES;
#pragma unroll
    for (int jj = 0; jj < 8; ++jj) { const int k0 = 8 * (jj >> 2) + 4 * hi + (jj & 3); Ts0[jj] = (k0 >= r32) ? (_Float16)1.0f : (_Float16)0.0f; Ts1[jj] = (16 + k0 >= r32) ? (_Float16)1.0f : (_Float16)0.0f; ONES[jj] = (_Float16)1.0f; }
    const int tq = wid * 32 + r32;
#pragma unroll
    for (int j = 0; j < 4; ++j) { const int t = NT - 4 + j; const v4u kk = *(const v4u*)(ksrc + (long)t * 64 * D), vv = *(const v4u*)(vsrc + (long)t * 64 * D);
        *(LAS v4u*)(lds + AT_K + (t % 5) * AT_SLOT + sdst) = kk; *(LAS v4u*)(lds + AT_V + (t % 6) * AT_SLOT + sdst) = vv; }
    asm volatile("" : "+v"(qr[0]), "+v"(qr[1]), "+v"(qr[2]), "+v"(qr[3]));
    __syncthreads();
    LAS unsigned* flg = (LAS unsigned*)(lds + AT_FLAG);
    const int dw = NT - 4 + (wid >> 1);
    bool wdone = false;
    v4u kreg, vreg;
    if (wid < 4) {
        for (int it = 0; it < NT; ++it) {
            const int tn = NT - 5 - it, t = dw - it;
            if (tn >= 0) { kreg = *(const v4u*)(ksrc + (long)tn * 64 * D); vreg = *(const v4u*)(vsrc + (long)tn * 64 * D); }
            if (t < 0) wdone = true;
            if (!wdone) {
                const int kmin = 64 * (t - (NT - 4));
                const PFrag P = attn_front(kb0 + (t % 5) * AT_SLOT, qr, cvn, Ts0, Ts1, ONES, kmin + 63 >= wid * 32, kmin, tq, hi);
                attn_pv(o, vb0 + (t % 6) * AT_SLOT, P);
                wdone = __all(cvn[0] < -ATT_CUT);
            }
            if (tn >= 0) { *(LAS v4u*)(lds + AT_K + (tn % 5) * AT_SLOT + sdst) = kreg; *(LAS v4u*)(lds + AT_V + (tn % 6) * AT_SLOT + sdst) = vreg; }
            if (lane == 0) flg[(it & 1) * 8 + wid] = wdone ? 1u : 0u;
            __syncthreads();
            { const v4u f0 = *(const LAS v4u*)(flg + (it & 1) * 8), f1 = *(const LAS v4u*)(flg + (it & 1) * 8 + 4);
              if ((f0.x & f0.y & f0.z & f0.w & f1.x & f1.y & f1.z & f1.w) != 0u) break; }
        }
    } else {
        PFrag Pd; Pd.a0 = Pd.a1 = Pd.a2 = Pd.a3 = (bf16x8){0, 0, 0, 0, 0, 0, 0, 0}; bool have = false; int vprev = 0;
        for (int it = 0; it < NT; ++it) {
            const int tn = NT - 5 - it, t = dw - it;
            if (tn >= 0) { kreg = *(const v4u*)(ksrc + (long)tn * 64 * D); vreg = *(const v4u*)(vsrc + (long)tn * 64 * D); }
            if (have) { attn_pv(o, vb0 + vprev, Pd); have = false; }
            if (t < 0) wdone = true;
            if (!wdone) {
                const int kmin = 64 * (t - (NT - 4));
                Pd = attn_front(kb0 + (t % 5) * AT_SLOT, qr, cvn, Ts0, Ts1, ONES, kmin + 63 >= wid * 32, kmin, tq, hi); have = true; vprev = (t % 6) * AT_SLOT;
                wdone = __all(cvn[0] < -ATT_CUT);
            }
            if (tn >= 0) { *(LAS v4u*)(lds + AT_K + (tn % 5) * AT_SLOT + sdst) = kreg; *(LAS v4u*)(lds + AT_V + (tn % 6) * AT_SLOT + sdst) = vreg; }
            if (lane == 0) flg[(it & 1) * 8 + wid] = wdone ? 1u : 0u;
            __syncthreads();
            { const v4u f0 = *(const LAS v4u*)(flg + (it & 1) * 8), f1 = *(const LAS v4u*)(flg + (it & 1) * 8 + 4);
              if ((f0.x & f0.y & f0.z & f0.w & f1.x & f1.y & f1.z & f1.w) != 0u) break; }
        }
        if (have) attn_pv(o, vb0 + vprev, Pd);
    }
    bf16* Ow = O + (rowbase + q0 + wid * 32) * D + h * HD;
    LAS bf16* stg = (LAS bf16*)(lds + AT_OST + wid * 4096);
#pragma unroll
    for (int r = 0; r < 16; ++r) { const int orow = crow(r, hi);
#pragma unroll
        for (int d0 = 0; d0 < 2; ++d0) stg[orow * 64 + d0 * 32 + r32] = (bf16)f2bf(o[d0][r]); }
    asm volatile("s_waitcnt lgkmcnt(0)" ::: "memory");
#pragma unroll
    for (int i = 0; i < 4; ++i) { const int row = i * 8 + (lane >> 3), ch = lane & 7; const v4u v = *(const LAS v4u*)(stg + row * 64 + ch * 8); if (wt) pg8::st16_wt(Ow + (long)row * D + ch * 8, v); else *(v4u*)(Ow + (long)row * D + ch * 8) = v; }
    asm volatile("s_waitcnt lgkmcnt(0)" ::: "memory");
    __syncthreads();
}

__device__ __forceinline__ void attn_phase(const Frame& F, const Args& a) {
    unsigned char* ws = a.ws;
    const bf16* Q = (const bf16*)(ws + WS_BIG); const bf16* K = (const bf16*)(ws + WS_BIG + 32 * MiB); const bf16* V = (const bf16*)(ws + WS_BIG + 64 * MiB); bf16* O = (bf16*)(ws + WS_BIG);
    const int nslots = (BATCH * H * 2);
    for (int sv = F.vcu; sv < nslots; sv += F.G) {
        const int bh = sv >> 1, odd = sv & 1;
#pragma unroll 1
        for (int i = 0; i < 4; ++i) { const int base = (i == 0) ? 0 : (i == 1) ? 7 : (i == 2) ? 2 : 5; const int qb = odd ? ((i & 1) ? base - 1 : base + 1) : base;
            attn_unit(bh / H, bh % H, qb, Q, K, V, O, F.lds, i == 3 && sv + F.G >= nslots); }
    }
}

#define XB_TMO      128
#define XB_XCNT(j)  (256  + 64 * (j))
#define XB_XSUB(j)  (1280 + 64 * (j))
#define XB_XGEN(j)  (2304 + 64 * (j))
#define XB_TOP      3328
#define XB_TOPGEN   3392
#define XCD_BAR_WORDS 3456
#define XB_SPIN_CAP (1u << 18)

__device__ __forceinline__ unsigned xb_ld(unsigned* p)              { return __hip_atomic_load(p, __ATOMIC_RELAXED, __HIP_MEMORY_SCOPE_AGENT); }
__device__ __forceinline__ unsigned xb_add(unsigned* p, unsigned v) { return __hip_atomic_fetch_add(p, v, __ATOMIC_RELAXED, __HIP_MEMORY_SCOPE_AGENT); }
__device__ __forceinline__ unsigned xb_xcc_id() { return (unsigned)__builtin_amdgcn_s_getreg((3 << 11) | 20) & 0xFu; }
#define XB_SPIN(cond, bar) do { unsigned _sp = 0; while (cond) { \
    if ((++_sp & 255u) == 0u) { if (xb_ld(&(bar)[XB_TMO])) break; if (_sp > XB_SPIN_CAP) { atomicAdd(&(bar)[XB_TMO], 1u); break; } } } } while (0)

struct XcdBarrier {
    unsigned* bar; unsigned x;
    volatile LAS unsigned* st;
};

__device__ __forceinline__ XcdBarrier xcd_barrier_post(unsigned* bar, volatile LAS unsigned* st) {
    XcdBarrier b; b.bar = bar; b.x = xb_xcc_id(); b.st = st;
    if (threadIdx.x == 0) (void)xb_add(&bar[XB_XCNT(b.x)], 1u);
    return b;
}
__device__ __forceinline__ void xcd_barrier_complete(unsigned* bar, unsigned x, unsigned& nloc, unsigned& nx) {
    const unsigned G = gridDim.x * gridDim.y * gridDim.z;
    unsigned sum, cnt, mine, sp = 0u;
    for (;;) {
        sum = 0u; cnt = 0u; mine = 0u;
#pragma unroll
        for (unsigned j = 0; j < 16; ++j) { const unsigned c = xb_ld(&bar[XB_XCNT(j)]); sum += c; cnt += (c > 0u) ? 1u : 0u; mine = (j == x) ? c : mine; }
        if (sum == G) break;
        __builtin_amdgcn_s_sleep(1);
        if ((++sp & 255u) == 0u) { if (xb_ld(&bar[XB_TMO])) break; if (sp > XB_SPIN_CAP) { atomicAdd(&bar[XB_TMO], 1u); break; } }
    }
    nloc = mine > 0u ? mine : 1u; nx = cnt > 0u ? cnt : 1u;
}

__device__ __forceinline__ void xcd_barrier(const XcdBarrier& b) {
    asm volatile("s_waitcnt vmcnt(0)" ::: "memory");
    __syncthreads();
    if (threadIdx.x == 0) {
        unsigned* bar = b.bar;
        __builtin_amdgcn_s_waitcnt(0);
        unsigned nloc = b.st[0], nx = b.st[1];
        if (nloc == 0u) { xcd_barrier_complete(bar, b.x, nloc, nx); b.st[0] = nloc; b.st[1] = nx; }
        const unsigned old = xb_add(&bar[XB_XSUB(b.x)], 1u);
        const unsigned gen = old / nloc;
        if (old + 1u == (gen + 1u) * nloc) {
            __builtin_amdgcn_fence(__ATOMIC_RELEASE, "agent");
            asm volatile("s_waitcnt vmcnt(0)" ::: "memory");
            const unsigned og = xb_add(&bar[XB_TOP], 1u);
            const unsigned tg = og / nx;
            if (og + 1u == (tg + 1u) * nx) xb_add(&bar[XB_TOPGEN], 1u);
            else XB_SPIN(xb_ld(&bar[XB_TOPGEN]) == tg, bar);
            __builtin_amdgcn_fence(__ATOMIC_ACQUIRE, "agent");
            xb_add(&bar[XB_XGEN(b.x)], 1u);
            asm volatile("s_waitcnt vmcnt(0)" ::: "memory");
        } else {
            XB_SPIN(xb_ld(&bar[XB_XGEN(b.x)]) == gen, bar);
            __builtin_amdgcn_fence(__ATOMIC_ACQUIRE, "agent");
            asm volatile("s_waitcnt vmcnt(0)" ::: "memory");
        }
    }
    __syncthreads();
}

enum { ST_PRO = 0, ST_WIN, ST_SGU, ST_WOA, ST_UP0, ST_DN0, ST_PP0, ST_GATE0, ST_QKV, ST_ATT, ST_WOB, ST_UP1, ST_DN1, ST_PP1, ST_GATE1, ST_N };
__host__ __device__ __forceinline__ bool sync_after(int st) { return !(st == ST_PP0 || st == ST_PP1 || st == ST_GATE1); }

template <int ST> __device__ __forceinline__ void run_step(const Args& args, const Frame& F, unsigned char* ws) {
    asm volatile("" : "+s"(ws));
    float* ssq = (float*)(ws + WS_SSQ);
#define SSQ(i) (ssq + (size_t)(i) * M * 16)
    bf16* XB = (bf16*)(ws + WS_XB); bf16* BIG = (bf16*)(ws + WS_BIG); bf16* XB3 = (bf16*)(ws + WS_BIG + 96 * MiB);
    typedef pg8::EpiResT<false> ResN; typedef pg8::EpiResT<true> ResF;
    constexpr int l = (ST >= ST_WOB) ? 1 : 0;
    if constexpr (ST == ST_PRO) prologue_phase(F, args);
    else if constexpr (ST == ST_SGU) sgu_phase(F, args);
    else if constexpr (ST == ST_ATT) attn_phase(F, args);
    else if constexpr (ST == ST_WIN) { const pg8::Gemm g{XB, (const bf16*)(ws + WS_WIN), M, 2 * D, D}; const pg8::EpiAct E{BIG, 2 * D, SSQ(SQ_X0), SSQ(SQ_V), 1};
        pg8::StaticOrder S; S.init(g.M, g.N, F.G, (int)blockIdx.x); pg8::gemm_phase<pg8::EpiAct, pg8::StaticOrder, true, true>(F.lds, g, S, E); }
    else if constexpr (ST == ST_WOA) { const pg8::Gemm g{(const bf16*)(ws + WS_BIG + 64 * MiB), (const bf16*)(ws + WS_WOA), M, D, D}; const ResN E{XB, XB, nullptr, SSQ(SQ_X1), nullptr, nullptr, 0};
        pg8::StaticOrder S; S.init(g.M, g.N, F.G, (int)blockIdx.x); pg8::gemm_phase<ResN, pg8::StaticOrder, true, true>(F.lds, g, S, E); }
    else if constexpr (ST == ST_UP0 || ST == ST_UP1) { const pg8::Gemm g{XB, (const bf16*)(ws + WS_WUP) + (size_t)l * D * FF, M, FF, D}; const pg8::EpiAct E{BIG, FF, SSQ(l ? SQ_X4 : SQ_X1), nullptr, 2};
        pg8::StaticOrder S; S.init(g.M, g.N, F.G, (int)blockIdx.x); pg8::gemm_phase<pg8::EpiAct, pg8::StaticOrder, true, true>(F.lds, g, S, E); }
    else if constexpr (ST == ST_DN0 || ST == ST_DN1) { const pg8::Gemm g{BIG, (const bf16*)(ws + WS_WDN) + (size_t)l * D * FF, M, D, FF}; const ResN E{XB, XB, nullptr, SSQ(l ? SQ_X5 : SQ_X2), nullptr, nullptr, 0};
        pg8::StaticOrder S; S.init(g.M, g.N, F.G, (int)blockIdx.x); pg8::gemm_phase<ResN, pg8::StaticOrder, true, true>(F.lds, g, S, E); }
    else if constexpr (ST == ST_PP0 || ST == ST_PP1) { const pg8::Gemm g{(const bf16*)(ws + WS_PBF) + (size_t)l * M * PLE, (const bf16*)(ws + WS_WPP) + (size_t)l * PLE * D, M, D, PLE}; const pg8::EpiAct E{BIG, D, nullptr, nullptr, 0};
        pg8::StaticOrder S; S.init(g.M, g.N, F.G, (int)blockIdx.x); pg8::gemm_phase<pg8::EpiAct, pg8::StaticOrder, true, true>(F.lds, g, S, E); }
    else if constexpr (ST == ST_GATE0) { const pg8::Gemm g{XB, (const bf16*)(ws + WS_WG), M, D, D}; const ResN E{XB, XB3, nullptr, SSQ(SQ_X3), SSQ(SQ_X2), BIG, 1};
        pg8::StaticOrder S; S.init(g.M, g.N, F.G, (int)blockIdx.x); pg8::gemm_phase<ResN, pg8::StaticOrder, true, true>(F.lds, g, S, E); }
    else if constexpr (ST == ST_GATE1) { const pg8::Gemm g{XB, (const bf16*)(ws + WS_WG) + (size_t)D * D, M, D, D}; const ResF E{XB, nullptr, args.out, nullptr, SSQ(SQ_X5), BIG, 1};
        pg8::StaticOrder S; S.init(g.M, g.N, F.G, (int)blockIdx.x); pg8::gemm_phase<ResF, pg8::StaticOrder, true, true>(F.lds, g, S, E); }
    else if constexpr (ST == ST_QKV) { const pg8::Gemm g{XB3, (const bf16*)(ws + WS_WQKV), M, 3 * D, D}; const pg8::EpiQKV E{BIG, (size_t)M * D, SSQ(SQ_X3), args.in[13], args.in[10]};
        pg8::StaticOrder S; S.init(g.M, g.N, F.G, (int)blockIdx.x); pg8::gemm_phase<pg8::EpiQKV, pg8::StaticOrder, true, true>(F.lds, g, S, E); }
    else if constexpr (ST == ST_WOB) { const pg8::Gemm g{BIG, (const bf16*)(ws + WS_WOB), M, D, D}; const ResN E{XB3, XB, nullptr, SSQ(SQ_X4), nullptr, nullptr, 0};
        pg8::StaticOrder S; S.init(g.M, g.N, F.G, (int)blockIdx.x); pg8::gemm_phase<ResN, pg8::StaticOrder, true, true>(F.lds, g, S, E); }
#undef SSQ
}

__global__ void __launch_bounds__(NWAVES * 64, 2) yoco_fwd(Args args) {
    extern __shared__ __attribute__((aligned(16))) unsigned char lds[];
    cg::grid_group grid = cg::this_grid();
    Frame F; F.lds = (LAS unsigned char*)lds;
    F.G = gridDim.x; { const int bx = blockIdx.x; F.vcu = (F.G % 8 == 0) ? (bx % 8) * (F.G / 8) + bx / 8 : bx; }
    unsigned char* ws = args.ws;
    volatile LAS unsigned* MISC = (volatile LAS unsigned*)(F.lds + 131072 + 320);
    if (threadIdx.x < 32) MISC[threadIdx.x] = 0u;
    __syncthreads();
    XcdBarrier bar = xcd_barrier_post((unsigned*)(ws + WS_CTL) + 4096, MISC + 8);
#define STEP(k) do { if (args.lo <= (k) && (k) < args.hi) { run_step<(k)>(args, F, ws); \
        if ((k) + 1 < args.hi && sync_after(k)) { if (args.hi > 1000) grid.sync(); else xcd_barrier(bar); } else __syncthreads(); } } while (0)
    STEP(0); STEP(1); STEP(2); STEP(3); STEP(4); STEP(5); STEP(6); STEP(7); STEP(8); STEP(9); STEP(10); STEP(11); STEP(12); STEP(13); STEP(14);
#undef STEP
    static_assert(ST_N == 15, "the STEP list covers every step");
}

extern "C" void kernel_launch(void* const* d_in, const int* in_sizes, int n_in, void* d_out, int out_size, void* d_ws, size_t ws_size, hipStream_t stream) {
    static int grid = 0;
    if (grid == 0) {
        if (n_in != 21 || in_sizes[0] != M * D || out_size != M * D || ws_size < WS_END) { fprintf(stderr, "kernel_launch: unexpected shapes (n_in %d, in0 %d, out %d, ws %zu)\n", n_in, n_in > 0 ? in_sizes[0] : -1, out_size, ws_size); grid = -1; return; }
        int dev = 0, cus = 0, per_cu = 0;
        if (hipGetDevice(&dev) != hipSuccess || hipDeviceGetAttribute(&cus, hipDeviceAttributeMultiprocessorCount, dev) != hipSuccess) { grid = -1; return; }
        if (hipFuncSetAttribute((const void*)yoco_fwd, hipFuncAttributeMaxDynamicSharedMemorySize, LDS_BYTES) != hipSuccess) { fprintf(stderr, "kernel_launch: hipFuncSetAttribute failed\n"); grid = -1; return; }
        if (hipOccupancyMaxActiveBlocksPerMultiprocessor(&per_cu, (const void*)yoco_fwd, NWAVES * 64, LDS_BYTES) != hipSuccess || per_cu < 1) { fprintf(stderr, "kernel_launch: occupancy query says %d blocks per CU\n", per_cu); (void)hipGetLastError(); grid = -1; return; }
        grid = cus;
    }
    if (grid < 0) return;
    if (hipMemsetAsync((char*)d_ws + WS_CTL, 0, 65536, stream) != hipSuccess) { fprintf(stderr, "kernel_launch: hipMemsetAsync failed\n"); return; }
    Args a{};
    for (int i = 0; i < 21; ++i) a.in[i] = (const float*)d_in[i];
    a.out = (float*)d_out; a.ws = (unsigned char*)d_ws;
#if MK_SINGLE
    a.lo = 0; a.hi = ST_N;
    void* params[] = {&a};
    hipError_t e = hipLaunchCooperativeKernel((const void*)yoco_fwd, dim3(grid), dim3(NWAVES * 64), params, LDS_BYTES, stream);
    if (e != hipSuccess) fprintf(stderr, "kernel_launch: cooperative launch failed: %s (grid %d)\n", hipGetErrorString(e), grid);
#else
    int lo = 0;
    for (int st = 0; st < ST_N; ++st) {
        if (sync_after(st) || st == ST_N - 1) {
            a.lo = lo; a.hi = st + 1; lo = st + 1;
            void* params[] = {&a};
            hipError_t e = hipLaunchCooperativeKernel((const void*)yoco_fwd, dim3(grid), dim3(NWAVES * 64), params, LDS_BYTES, stream);
            if (e != hipSuccess) { fprintf(stderr, "kernel_launch: launch of steps [%d,%d) failed: %s\n", a.lo, a.hi, hipGetErrorString(e)); break; }
        }
    }
#endif
}
```

```cpp
#include <hip/hip_runtime.h>
#include <hip/hip_cooperative_groups.h>
#include <cstdio>
#include <cstdint>
#include <cmath>
namespace cg = cooperative_groups;
namespace pg8 {
#define PG8_LAS __attribute__((address_space(3)))
typedef unsigned short bf16_t;
typedef short bf16x8 __attribute__((ext_vector_type(8)));
typedef float f32x4 __attribute__((ext_vector_type(4)));
typedef unsigned u32x4 __attribute__((ext_vector_type(4)));
typedef unsigned u32x2 __attribute__((ext_vector_type(2)));
constexpr int BM = 256, BK = 64, HALF = 128, HTB = HALF * BK * 2  , STAGE_BYTES = 8 * HTB, NXCD = 8, WGM = 8;

__host__ __device__ __forceinline__ int lds_byte(int r, int c) { const int st = (r >> 4) * 2 + (c >> 5), rr = r & 15, cc = c & 31, ob = rr * 64 + cc * 2; return st * 1024 + (ob ^ (((ob >> 9) & 1) << 5)); }
__host__ __device__ __forceinline__ void stage_rc(int b, int& R, int& C) { const int st = b / 1024, sb = b % 1024, swz = sb ^ (((sb >> 9) & 1) << 5); R = (st >> 1) * 16 + swz / 64; C = (st & 1) * 32 + (swz % 64) / 2; }
__host__ __device__ __forceinline__ int perm32(int rho) { const int n = rho >> 4, i = rho & 15; return 8 * (i >> 2) + 4 * n + (i & 3); }

struct Unit { int pm, pn; };
struct Gemm { const bf16_t* A; const bf16_t* Bt; int M, N, K; };

struct StaticOrder {
    int nM, nN, nwg, G, c;
    __host__ __device__ void init(int M, int N, int G_, int c_) { nM = M / BM; nN = N / BM; nwg = nM * nN; G = G_; c = c_; }
    __host__ __device__ bool next(int i, Unit& u) const {
        const long L = (long)i * G + c; if (L >= nwg) return false;
        int wgid = (int)L; { const int q = nwg / NXCD, r = nwg % NXCD, xcd = wgid % NXCD, off = wgid / NXCD; wgid = (xcd < r ? xcd * (q + 1) : r * (q + 1) + (xcd - r) * q) + off; }
        const int nig = WGM * nN, gid = wgid / nig, fm = gid * WGM, gsz = (nM - fm) < WGM ? (nM - fm) : WGM;
        u.pm = fm + ((wgid % nig) % gsz); u.pn = (wgid % nig) / gsz; return true;
    }
    __device__ __forceinline__ void a_ready(const Unit&) const {}
    __device__ __forceinline__ void done(const Unit&) const {}
};
__device__ __forceinline__ unsigned cvt_pk_bf16(float lo, float hi) { unsigned r; asm volatile("v_cvt_pk_bf16_f32 %0, %1, %2" : "=v"(r) : "v"(lo), "v"(hi)); return r; }
typedef float f32x2 __attribute__((ext_vector_type(2)));
__device__ __forceinline__ void rs8_issue(f32x4 (&v)[2][4], const float* ssq, int row0, int fq) {
#pragma unroll
    for (int ai = 0; ai < 2; ++ai)
#pragma unroll
        for (int m = 0; m < 4; ++m) v[ai][m] = *(const f32x4*)(ssq + (size_t)(row0 + ai * HALF + m * 16) * 16 + 4 * fq);
}
__device__ __forceinline__ void rs8_finish(float (&rs)[2][4], const f32x4 (&v)[2][4]) {
#pragma unroll
    for (int ai = 0; ai < 2; ++ai)
#pragma unroll
        for (int m = 0; m < 4; ++m) { float s = (v[ai][m][0] + v[ai][m][1]) + (v[ai][m][2] + v[ai][m][3]); s += __shfl_xor(s, 16); s += __shfl_xor(s, 32); rs[ai][m] = __builtin_amdgcn_rsqf(s * (1.0f / 1024.0f) + 1e-6f); }
}
template <class Epi, class Sched, bool ALIGN_EPI = false, bool SP2 = false>
__device__ __forceinline__ void gemm_phase(PG8_LAS unsigned char* lds, const Gemm g, const Sched& S, const Epi& E) {
    int tid_ = threadIdx.x; asm volatile("" : "+v"(tid_));
    const int tid = tid_, wid = __builtin_amdgcn_readfirstlane(tid >> 6), lane = tid & 63, wr = wid >> 2, wc = wid & 3, fr = lane & 15, fq = lane >> 4;
    const int K = g.K, nt = K / BK;
    unsigned voffA[2], voffB[2];
#pragma unroll
    for (int i = 0; i < 2; ++i) { int R, C; stage_rc(tid * 16 + i * 8192, R, C); const int Rb = Epi::PERM ? ((R & ~31) + perm32(R & 31)) : R;
        voffA[i] = (unsigned)(R * K + C) * 2u; voffB[i] = (unsigned)(Rb * K + C) * 2u; }
    const size_t kstep = (size_t)(BK * 2);
    const size_t hstep = (size_t)HALF * K * 2;
    const size_t tstep = 2 * hstep;
    const unsigned ldsw = (unsigned)wid * 1024u;
    const int aoff = lds_byte(wr * 64 + fr, fq * 8), boff = lds_byte(wc * 32 + fr, fq * 8);
#define PG8_SA(b, h) (((b) * 2 + (h)) * HTB)
#define PG8_SB(b, h) ((4 + (b) * 2 + (h)) * HTB)
#define PG8_STAGE(bufoff, gbase, voff) do { _Pragma("unroll") for (int _i = 0; _i < 2; ++_i) \
        __builtin_amdgcn_global_load_lds((const unsigned*)((const char*)(gbase) + (voff)[_i]), (PG8_LAS unsigned*)(lds + (bufoff) + ldsw + _i * 8192), 16, 0, 0); } while (0)
#define PG8_LDA(dst, b, h) do { _Pragma("unroll") for (int m = 0; m < 4; ++m) _Pragma("unroll") for (int k = 0; k < 2; ++k) dst[m][k] = *(const PG8_LAS bf16x8*)(lds + PG8_SA(b, h) + aoff + m * 2048 + k * 1024); } while (0)
#define PG8_LDB(dst, b, h) do { _Pragma("unroll") for (int n = 0; n < 2; ++n) _Pragma("unroll") for (int k = 0; k < 2; ++k) dst[n][k] = *(const PG8_LAS bf16x8*)(lds + PG8_SB(b, h) + boff + n * 2048 + k * 1024); } while (0)
#define PG8_MMA(ai, bj, At, Bt) do { __builtin_amdgcn_s_setprio(1); _Pragma("unroll") for (int m = 0; m < 4; ++m) _Pragma("unroll") for (int n = 0; n < 2; ++n) _Pragma("unroll") for (int k = 0; k < 2; ++k) \
        acc[ai][bj][m][n] = __builtin_amdgcn_mfma_f32_16x16x32_bf16(Bt[n][k], At[m][k], acc[ai][bj][m][n], 0, 0, 0); __builtin_amdgcn_s_setprio(0); } while (0)
#define PG8_WAIT_V(n) asm volatile("s_waitcnt vmcnt(" #n ")" ::: "memory")
#define PG8_WAIT_L(n) asm volatile("s_waitcnt lgkmcnt(" #n ")" ::: "memory")
#define PG8_BAR __builtin_amdgcn_s_barrier()
#define PG8_SCHED __builtin_amdgcn_sched_barrier(0)
    Unit cur, nxt; int ui = 0;
    if (!S.next(0, cur)) return;
    f32x4 acc[2][2][4][2];
    float rs8[2][4];
#pragma unroll
    for (int a_ = 0; a_ < 2; ++a_)
#pragma unroll
        for (int m_ = 0; m_ < 4; ++m_) rs8[a_][m_] = 1.0f;
    bf16x8 At[4][2], B0[2][2], B1[2][2];
    const char* cA = (const char*)g.A + (size_t)cur.pm * tstep; const char* cB = (const char*)g.Bt + (size_t)cur.pn * tstep;
    S.a_ready(cur);
    if constexpr (SP2) {
        PG8_STAGE(PG8_SB(0, 0), cB, voffB); PG8_STAGE(PG8_SB(0, 1), cB + hstep, voffB); PG8_STAGE(PG8_SA(0, 0), cA, voffA); PG8_STAGE(PG8_SA(0, 1), cA + hstep, voffA);
        E.init(acc, cur, wr, wc, fr, fq);
        { f32x4 raw_[2][4]; if (E.rs_src()) { rs8_issue(raw_, E.rs_src(), cur.pm * BM + wr * 64 + fr, fq); rs8_finish(rs8, raw_); } }
        if (wr == 1) PG8_BAR;
        PG8_WAIT_V(2); PG8_BAR;
        PG8_STAGE(PG8_SB(1, 0), cB + kstep, voffB); PG8_STAGE(PG8_SA(1, 0), cA + kstep, voffA); PG8_STAGE(PG8_SB(1, 1), cB + hstep + kstep, voffB);
        PG8_WAIT_V(6); PG8_BAR;
    } else {
        PG8_STAGE(PG8_SB(0, 0), cB, voffB); PG8_STAGE(PG8_SA(0, 0), cA, voffA); PG8_STAGE(PG8_SB(0, 1), cB + hstep, voffB); PG8_STAGE(PG8_SA(0, 1), cA + hstep, voffA);
        E.init(acc, cur, wr, wc, fr, fq);
        { f32x4 raw_[2][4]; if (E.rs_src()) { rs8_issue(raw_, E.rs_src(), cur.pm * BM + wr * 64 + fr, fq); rs8_finish(rs8, raw_); } }
        if (wr == 1) PG8_BAR;
        PG8_WAIT_V(4); PG8_BAR;
        PG8_STAGE(PG8_SB(1, 0), cB + kstep, voffB); PG8_STAGE(PG8_SA(1, 0), cA + kstep, voffA); PG8_STAGE(PG8_SB(1, 1), cB + hstep + kstep, voffB);
        PG8_WAIT_V(6); PG8_BAR;
    }
    for (;;) {
        const bool has_next = S.next(ui + 1, nxt);
        const char* nA = has_next ? (const char*)g.A + (size_t)nxt.pm * tstep : cA; const char* nB = has_next ? (const char*)g.Bt + (size_t)nxt.pn * tstep : cB;
        for (int t = 0; t < nt; t += 2) {
            const bool last = (t == nt - 2);
            const char* a1 = cA + (size_t)(t + 1) * kstep;
            const char* a2 = last ? nA : cA + (size_t)(t + 2) * kstep; const char* b2 = last ? nB : cB + (size_t)(t + 2) * kstep;
            const char* a3 = a2 + kstep; const char* b3 = b2 + kstep;
            if (last && has_next) S.a_ready(nxt);
            if constexpr (SP2) {
            PG8_LDB(B0, 0, 0); PG8_LDB(B1, 0, 1); PG8_SCHED; PG8_LDA(At, 0, 0); PG8_STAGE(PG8_SA(1, 1), a1 + hstep, voffA);
            PG8_WAIT_V(8); PG8_WAIT_L(0); PG8_BAR; PG8_MMA(0, 0, At, B0); PG8_MMA(0, 1, At, B1); PG8_BAR; PG8_SCHED;
            PG8_LDA(At, 0, 1); PG8_STAGE(PG8_SB(0, 0), b2, voffB); PG8_STAGE(PG8_SB(0, 1), b2 + hstep, voffB); PG8_STAGE(PG8_SA(0, 0), a2, voffA);
            PG8_WAIT_V(8); PG8_WAIT_L(0); PG8_BAR; PG8_MMA(1, 0, At, B0); PG8_MMA(1, 1, At, B1); PG8_BAR; PG8_SCHED;
            PG8_LDB(B0, 1, 0); PG8_LDB(B1, 1, 1); PG8_SCHED; PG8_LDA(At, 1, 0); PG8_STAGE(PG8_SA(0, 1), a2 + hstep, voffA);
            PG8_WAIT_V(8); PG8_WAIT_L(0); PG8_BAR; PG8_MMA(0, 0, At, B0); PG8_MMA(0, 1, At, B1); PG8_BAR; PG8_SCHED;
            PG8_LDA(At, 1, 1); PG8_STAGE(PG8_SB(1, 0), b3, voffB); PG8_STAGE(PG8_SB(1, 1), b3 + hstep, voffB); PG8_STAGE(PG8_SA(1, 0), a3, voffA);
            PG8_WAIT_V(8); PG8_WAIT_L(0); PG8_BAR; PG8_MMA(1, 0, At, B0); PG8_MMA(1, 1, At, B1); PG8_BAR; PG8_SCHED;
            } else {
            PG8_LDB(B0, 0, 0); PG8_SCHED; PG8_LDA(At, 0, 0); PG8_STAGE(PG8_SA(1, 1), a1 + hstep, voffA);
            PG8_WAIT_L(8); PG8_BAR; PG8_WAIT_L(0); PG8_MMA(0, 0, At, B0); PG8_BAR; PG8_SCHED;
            PG8_LDB(B1, 0, 1); PG8_STAGE(PG8_SB(0, 0), b2, voffB);
            PG8_BAR; PG8_WAIT_L(0); PG8_MMA(0, 1, At, B1); PG8_BAR;
            PG8_LDA(At, 0, 1); PG8_STAGE(PG8_SA(0, 0), a2, voffA);
            PG8_BAR; PG8_WAIT_L(0); PG8_MMA(1, 0, At, B0); PG8_BAR; PG8_SCHED;
            PG8_STAGE(PG8_SB(0, 1), b2 + hstep, voffB);
            PG8_WAIT_V(6); PG8_BAR; PG8_MMA(1, 1, At, B1); PG8_BAR;
            PG8_LDB(B0, 1, 0); PG8_SCHED; PG8_LDA(At, 1, 0); PG8_STAGE(PG8_SA(0, 1), a2 + hstep, voffA);
            PG8_WAIT_L(8); PG8_BAR; PG8_WAIT_L(0); PG8_MMA(0, 0, At, B0); PG8_BAR; PG8_SCHED;
            PG8_LDB(B1, 1, 1); PG8_STAGE(PG8_SB(1, 0), b3, voffB);
            PG8_BAR; PG8_WAIT_L(0); PG8_MMA(0, 1, At, B1); PG8_BAR;
            PG8_LDA(At, 1, 1); PG8_STAGE(PG8_SA(1, 0), a3, voffA);
            PG8_BAR; PG8_WAIT_L(0); PG8_MMA(1, 0, At, B0); PG8_BAR; PG8_SCHED;
            PG8_STAGE(PG8_SB(1, 1), b3 + hstep, voffB);
            PG8_WAIT_V(6); PG8_BAR; PG8_MMA(1, 1, At, B1); PG8_BAR;
            }
        }
        if constexpr (ALIGN_EPI) { if (wr == 0) PG8_BAR; }
        if constexpr (!Epi::AFTER_DRAIN) { E(acc, rs8, cur, wr, wc, fr, fq, !has_next); S.done(cur); }
        if (has_next && E.rs_src()) { f32x4 rawn[2][4]; rs8_issue(rawn, E.rs_src(), nxt.pm * BM + wr * 64 + fr, fq); rs8_finish(rs8, rawn); }
        if (!has_next) break;
        E.init(acc, nxt, wr, wc, fr, fq);
        cur = nxt; cA = nA; cB = nB; ++ui;
        if constexpr (ALIGN_EPI) { if (wr == 1) PG8_BAR; }
    }
    PG8_WAIT_V(0);
    if constexpr (!ALIGN_EPI) { if (wr == 0) PG8_BAR; }
    PG8_BAR;
    if constexpr (Epi::AFTER_DRAIN) { E.fused(acc, cur, wr, wc, fr, fq, lds, wid, lane); S.done(cur); }
#undef PG8_SA
#undef PG8_SB
#undef PG8_STAGE
#undef PG8_LDA
#undef PG8_LDB
#undef PG8_MMA
#undef PG8_WAIT_V
#undef PG8_WAIT_L
#undef PG8_BAR
#undef PG8_SCHED
}
}

namespace pg8 {
constexpr float kEps = 1e-6f;
constexpr float kLog2e = 1.4426950408889634f;
constexpr float kC2 = 0.125f * 1.4426950408889634f;
__device__ __forceinline__ float rsq_f(float v) { return __builtin_amdgcn_rsqf(v); }
__device__ __forceinline__ float row_rs(const float* ssq, int row, int fq) {
    const f32x4 v = *(const f32x4*)(ssq + (size_t)row * 16 + 4 * fq);
    float s = (v[0] + v[1]) + (v[2] + v[3]);
    s += __shfl_xor(s, 16); s += __shfl_xor(s, 32);
    return rsq_f(s * (1.0f / 1024.0f) + kEps);
}
__device__ __forceinline__ void acc_zero(f32x4 (&acc)[2][2][4][2]) {
#pragma unroll
    for (int a = 0; a < 2; ++a)
#pragma unroll
        for (int b = 0; b < 2; ++b)
#pragma unroll
            for (int m = 0; m < 4; ++m)
#pragma unroll
                for (int n = 0; n < 2; ++n) acc[a][b][m][n] = (f32x4){0.f, 0.f, 0.f, 0.f};
}
__device__ __forceinline__ void row_rs8(float (&rs)[2][4], const float* ssq, int row0, int fq) {
    f32x4 v[2][4];
#pragma unroll
    for (int ai = 0; ai < 2; ++ai)
#pragma unroll
        for (int m = 0; m < 4; ++m) v[ai][m] = *(const f32x4*)(ssq + (size_t)(row0 + ai * HALF + m * 16) * 16 + 4 * fq);
#pragma unroll
    for (int ai = 0; ai < 2; ++ai)
#pragma unroll
        for (int m = 0; m < 4; ++m) { float s = (v[ai][m][0] + v[ai][m][1]) + (v[ai][m][2] + v[ai][m][3]); s += __shfl_xor(s, 16); s += __shfl_xor(s, 32); rs[ai][m] = rsq_f(s * (1.0f / 1024.0f) + kEps); }
}
__device__ __forceinline__ void st16(void* p, u32x4 v) { asm volatile("global_store_dwordx4 %0, %1, off\n\ts_nop 1" : : "v"(p), "v"(v) : "memory"); }
__device__ __forceinline__ void st16_wt(void* p, u32x4 v) { asm volatile("global_store_dwordx4 %0, %1, off sc1\n\ts_nop 1" : : "v"(p), "v"(v) : "memory"); }
__device__ __forceinline__ void st8_wt(void* p, u32x2 v) { asm volatile("global_store_dwordx2 %0, %1, off sc1\n\ts_nop 1" : : "v"(p), "v"(v) : "memory"); }
__device__ __forceinline__ void st16f(void* p, f32x4 v) { asm volatile("global_store_dwordx4 %0, %1, off\n\ts_nop 1" : : "v"(p), "v"(v) : "memory"); }
__device__ __forceinline__ float sigmoid_f(float y) { return __builtin_amdgcn_rcpf(1.0f + __builtin_amdgcn_exp2f(-kLog2e * y)); }
__device__ __forceinline__ float gelu_tanh_f(float x) {
    const float t = x * (1.0f + 0.044715f * x * x);
    return x * __builtin_amdgcn_rcpf(1.0f + __builtin_amdgcn_exp2f(-2.302208198f * t));
}
__device__ __forceinline__ float bf_lo(unsigned w) { return __uint_as_float(w << 16); }
__device__ __forceinline__ float bf_hi(unsigned w) { return __uint_as_float(w & 0xffff0000u); }

struct EpiAct {
    static constexpr bool PERM = true, AFTER_DRAIN = false;
    bf16_t* O; int ldc; const float* ssq_in; float* ssq_out; int act;
    __device__ __forceinline__ void init(f32x4 (&acc)[2][2][4][2], const Unit&, int, int, int, int) const { acc_zero(acc); }
    __device__ __forceinline__ const float* rs_src() const { return ssq_in; }
    __device__ __forceinline__ void operator()(const f32x4 (&acc)[2][2][4][2], const float (&rsa)[2][4], const Unit& u, int wr, int wc, int fr, int fq, bool wt) const {
        const int row0 = u.pm * BM + wr * 64 + fr, col0 = u.pn * BM + wc * 32 + 8 * fq;
        const bool want = (act == 1) && (u.pn >= 4);
#pragma unroll
        for (int ai = 0; ai < 2; ++ai)
#pragma unroll
            for (int m = 0; m < 4; ++m) {
                const int row = row0 + ai * HALF + m * 16;
                const float rs = ssq_in ? rsa[ai][m] : 1.0f;
                float q = 0.f;
#pragma unroll
                for (int bj = 0; bj < 2; ++bj) {
                    f32x4 v0 = acc[ai][bj][m][0] * rs, v1 = acc[ai][bj][m][1] * rs;
                    if (act == 1) {
#pragma unroll
                        for (int j = 0; j < 4; ++j) { v0[j] = gelu_tanh_f(v0[j]); v1[j] = gelu_tanh_f(v1[j]); }
                    } else if (act == 2) {
#pragma unroll
                        for (int j = 0; j < 4; ++j) { const float a = fmaxf(v0[j], 0.f), b = fmaxf(v1[j], 0.f); v0[j] = a * a; v1[j] = b * b; }
                    }
                    if (want) q += (v0[0] * v0[0] + v0[1] * v0[1]) + (v0[2] * v0[2] + v0[3] * v0[3]) + (v1[0] * v1[0] + v1[1] * v1[1]) + (v1[2] * v1[2] + v1[3] * v1[3]);
                    u32x4 w; w.x = cvt_pk_bf16(v0[0], v0[1]); w.y = cvt_pk_bf16(v0[2], v0[3]); w.z = cvt_pk_bf16(v1[0], v1[1]); w.w = cvt_pk_bf16(v1[2], v1[3]);
                    if (wt) st16_wt(O + (size_t)row * ldc + col0 + bj * HALF, w); else *(u32x4*)(O + (size_t)row * ldc + col0 + bj * HALF) = w;
                }
                if (want) { q += __shfl_xor(q, 16); q += __shfl_xor(q, 32); if (fq == 0) ssq_out[(size_t)row * 16 + (u.pn - 4) * 4 + wc] = q; }
            }
    }
};

template <bool FINAL> struct EpiResT {
    static constexpr bool PERM = true, AFTER_DRAIN = false;
    const bf16_t* xr; bf16_t* xb; float* xout; float* ssq_out; const float* ssq_in; const bf16_t* pp; int gate;
    __device__ __forceinline__ void init(f32x4 (&acc)[2][2][4][2], const Unit& u, int wr, int wc, int fr, int fq) const {
        if (gate) { acc_zero(acc); return; }
        const int row0 = u.pm * BM + wr * 64 + fr, col0 = u.pn * BM + wc * 32 + 8 * fq;
        u32x4 w[2][4][2];
#pragma unroll
        for (int ai = 0; ai < 2; ++ai)
#pragma unroll
            for (int m = 0; m < 4; ++m)
#pragma unroll
                for (int bj = 0; bj < 2; ++bj) w[ai][m][bj] = *(const u32x4*)(xr + (size_t)(row0 + ai * HALF + m * 16) * 1024 + col0 + bj * HALF);
#pragma unroll
        for (int ai = 0; ai < 2; ++ai)
#pragma unroll
            for (int m = 0; m < 4; ++m)
#pragma unroll
                for (int bj = 0; bj < 2; ++bj) { const u32x4 t = w[ai][m][bj];
                    acc[ai][bj][m][0] = (f32x4){bf_lo(t.x), bf_hi(t.x), bf_lo(t.y), bf_hi(t.y)}; acc[ai][bj][m][1] = (f32x4){bf_lo(t.z), bf_hi(t.z), bf_lo(t.w), bf_hi(t.w)}; }
    }
    __device__ __forceinline__ const float* rs_src() const { return gate ? ssq_in : nullptr; }
    __device__ __forceinline__ void operator()(const f32x4 (&acc)[2][2][4][2], const float (&rsa)[2][4], const Unit& u, int wr, int wc, int fr, int fq, bool wt) const {
        const int row0 = u.pm * BM + wr * 64 + fr, col0 = u.pn * BM + wc * 32 + 8 * fq;
        u32x4 xa[2], pa[2];
        if (gate) {
#pragma unroll
            for (int bj = 0; bj < 2; ++bj) { const size_t off = (size_t)row0 * 1024 + col0 + bj * HALF; xa[bj] = *(const u32x4*)(xr + off); pa[bj] = *(const u32x4*)(pp + off); }
        }
#pragma unroll
        for (int ai = 0; ai < 2; ++ai)
#pragma unroll
            for (int m = 0; m < 4; ++m) {
                const int row = row0 + ai * HALF + m * 16;
                u32x4 xc[2], pc[2];
                if (gate) {
#pragma unroll
                    for (int bj = 0; bj < 2; ++bj) { xc[bj] = xa[bj]; pc[bj] = pa[bj]; }
                    if (ai * 4 + m < 7) { const int nrow = row0 + ((ai * 4 + m + 1) >> 2) * HALF + ((ai * 4 + m + 1) & 3) * 16;
#pragma unroll
                        for (int bj = 0; bj < 2; ++bj) { const size_t off = (size_t)nrow * 1024 + col0 + bj * HALF; xa[bj] = *(const u32x4*)(xr + off); pa[bj] = *(const u32x4*)(pp + off); } }
                }
                float q = 0.f;
#pragma unroll
                for (int bj = 0; bj < 2; ++bj) {
                    const size_t off = (size_t)row * 1024 + col0 + bj * HALF;
                    f32x4 v0 = acc[ai][bj][m][0], v1 = acc[ai][bj][m][1];
                    if (gate) {
                        const float rs = rsa[ai][m]; const u32x4 pw = pc[bj], xw = xc[bj];
                        v0[0] = bf_lo(xw.x) + bf_lo(pw.x) * sigmoid_f(rs * v0[0]); v0[1] = bf_hi(xw.x) + bf_hi(pw.x) * sigmoid_f(rs * v0[1]);
                        v0[2] = bf_lo(xw.y) + bf_lo(pw.y) * sigmoid_f(rs * v0[2]); v0[3] = bf_hi(xw.y) + bf_hi(pw.y) * sigmoid_f(rs * v0[3]);
                        v1[0] = bf_lo(xw.z) + bf_lo(pw.z) * sigmoid_f(rs * v1[0]); v1[1] = bf_hi(xw.z) + bf_hi(pw.z) * sigmoid_f(rs * v1[1]);
                        v1[2] = bf_lo(xw.w) + bf_lo(pw.w) * sigmoid_f(rs * v1[2]); v1[3] = bf_hi(xw.w) + bf_hi(pw.w) * sigmoid_f(rs * v1[3]);
                    }
                    if constexpr (FINAL) { *(f32x4*)(xout + off) = v0; *(f32x4*)(xout + off + 4) = v1; }
                    else {
                        q += (v0[0] * v0[0] + v0[1] * v0[1]) + (v0[2] * v0[2] + v0[3] * v0[3]) + (v1[0] * v1[0] + v1[1] * v1[1]) + (v1[2] * v1[2] + v1[3] * v1[3]);
                        u32x4 w; w.x = cvt_pk_bf16(v0[0], v0[1]); w.y = cvt_pk_bf16(v0[2], v0[3]); w.z = cvt_pk_bf16(v1[0], v1[1]); w.w = cvt_pk_bf16(v1[2], v1[3]);
                        if (wt) st16_wt(xb + off, w); else *(u32x4*)(xb + off) = w;
                    }
                }
                if constexpr (!FINAL) { q += __shfl_xor(q, 16); q += __shfl_xor(q, 32); if (fq == 0) ssq_out[(size_t)row * 16 + u.pn * 4 + wc] = q; }
            }
    }
};

struct EpiQKV {
    static constexpr bool PERM = true, AFTER_DRAIN = false;
    bf16_t* QKV; size_t tstride; const float* ssq_in; const float* gq; const float* gk;
    __device__ __forceinline__ void init(f32x4 (&acc)[2][2][4][2], const Unit&, int, int, int, int) const { acc_zero(acc); }
    __device__ __forceinline__ const float* rs_src() const { return ssq_in; }
    __device__ __forceinline__ void operator()(const f32x4 (&acc)[2][2][4][2], const float (&rsa)[2][4], const Unit& u, int wr, int wc, int fr, int fq, bool wt) const {
        const int row0 = u.pm * BM + wr * 64 + fr; const int t = u.pn >> 2;
        bf16_t* base = QKV + (size_t)t * tstride; const int colb = (u.pn & 3) * BM + 64 * wc + 8 * fq;
        const float* gp = (t == 0) ? gq : gk; const float sc = (t == 0) ? kC2 : 1.0f;
        f32x4 gg[2][2];
#pragma unroll
        for (int bj = 0; bj < 2; ++bj) { gg[bj][0] = (f32x4){1.f, 1.f, 1.f, 1.f}; gg[bj][1] = gg[bj][0]; if (t < 2) { gg[bj][0] = *(const f32x4*)(gp + 32 * bj + 8 * fq); gg[bj][1] = *(const f32x4*)(gp + 32 * bj + 8 * fq + 4); } }
#pragma unroll
        for (int ai = 0; ai < 2; ++ai)
#pragma unroll
            for (int m = 0; m < 4; ++m) {
                const int row = row0 + ai * HALF + m * 16;
                const float rs = rsa[ai][m];
                float q = 0.f;
#pragma unroll
                for (int bj = 0; bj < 2; ++bj)
#pragma unroll
                    for (int n = 0; n < 2; ++n) { const f32x4 a = acc[ai][bj][m][n]; q += (a[0] * a[0] + a[1] * a[1]) + (a[2] * a[2] + a[3] * a[3]); }
                q *= rs * rs;
                q += __shfl_xor(q, 16); q += __shfl_xor(q, 32);
                const float hn = ((t < 2) ? rsq_f(q * (1.0f / 64.0f) + kEps) * sc : 1.0f) * rs;
#pragma unroll
                for (int bj = 0; bj < 2; ++bj) {
                    const f32x4 v0 = acc[ai][bj][m][0] * hn * gg[bj][0], v1 = acc[ai][bj][m][1] * hn * gg[bj][1];
                    u32x4 w; w.x = cvt_pk_bf16(v0[0], v0[1]); w.y = cvt_pk_bf16(v0[2], v0[3]); w.z = cvt_pk_bf16(v1[0], v1[1]); w.w = cvt_pk_bf16(v1[2], v1[3]);
                    if (wt) st16_wt(base + (size_t)row * 1024 + colb + 32 * bj, w); else st16(base + (size_t)row * 1024 + colb + 32 * bj, w);
                }
            }
    }
};
}

#define LAS __attribute__((address_space(3)))
typedef unsigned short bf16;
typedef unsigned v4u __attribute__((ext_vector_type(4)));
typedef unsigned v2u __attribute__((ext_vector_type(2)));
typedef float f32x4 __attribute__((ext_vector_type(4)));
typedef float f32x16 __attribute__((ext_vector_type(16)));
typedef short bf16x8 __attribute__((ext_vector_type(8)));
typedef short s16x4 __attribute__((ext_vector_type(4)));
typedef _Float16 f16x8 __attribute__((ext_vector_type(8)));

#ifndef MK_SINGLE
#define MK_SINGLE 1
#endif

constexpr int NWAVES = 8;
constexpr int BATCH = 8, SEQ = 2048, D = 1024, H = 16, HD = 64, FF = 4096, PLE = 256, CHUNK = 128, NGRP = 8;
constexpr int M = BATCH * SEQ;
constexpr size_t MiB = 1u << 20;
constexpr size_t WS_CTL = 0;
constexpr size_t WS_SSQ = 1 * MiB;
constexpr size_t WS_WIN = 9 * MiB, WS_WOA = 13 * MiB, WS_WQKV = 15 * MiB, WS_WOB = 21 * MiB, WS_WUP = 23 * MiB, WS_WDN = 39 * MiB, WS_WG = 55 * MiB, WS_WPP = 59 * MiB;
constexpr size_t WS_PBF = 60 * MiB;
constexpr size_t WS_XB = 76 * MiB;
constexpr size_t WS_BIG = 108 * MiB;
constexpr size_t WS_END = 236 * MiB;
constexpr int LDS_BYTES = 147456;
enum { SQ_X0 = 0, SQ_V = 1, SQ_X1 = 2, SQ_X2 = 3, SQ_X3 = 4, SQ_X4 = 5, SQ_X5 = 6, SQ_X6 = 7 };

struct Args {
    const float* in[21];
    float* out; unsigned char* ws; int lo, hi;
};

struct Frame {
    LAS unsigned char* lds; int vcu, G;
};

__device__ __forceinline__ unsigned f2bf(float f) { unsigned u = __builtin_bit_cast(unsigned, f); return (u + 0x7fffu + ((u >> 16) & 1u)) >> 16; }
__device__ __forceinline__ unsigned pk2(float lo, float hi) { return f2bf(lo) | (f2bf(hi) << 16); }
__device__ __forceinline__ float wave_sum(float v) {
#pragma unroll
    for (int o = 1; o < 64; o <<= 1) v += __shfl_xor(v, o);
    return v;
}

__device__ __forceinline__ void tr_item(const float* W, int K, int N, const float* gain, bf16* WT, int row_off, bool headperm, LAS float* scr, int item, int lane) {
    const int nblk = N / 32, kb = item / nblk, nb = item % nblk, k0 = 64 * kb, n0 = 32 * nb;
    f32x4 w[8];
#pragma unroll
    for (int i = 0; i < 8; ++i) { const int idx = i * 64 + lane, kk = idx >> 3, n4 = idx & 7; w[i] = __builtin_nontemporal_load((const f32x4*)(W + (size_t)(k0 + kk) * N + n0 + 4 * n4)); }
    if (gain) {
#pragma unroll
        for (int i = 0; i < 8; ++i) { const int kk = (i * 64 + lane) >> 3; w[i] = w[i] * gain[k0 + kk]; }
    }
#pragma unroll
    for (int i = 0; i < 8; ++i) { const int idx = i * 64 + lane, kk = idx >> 3, n4 = idx & 7; LAS float* d = scr + kk * 33 + 4 * n4; d[0] = w[i][0]; d[1] = w[i][1]; d[2] = w[i][2]; d[3] = w[i][3]; }
    asm volatile("s_waitcnt lgkmcnt(0)" ::: "memory");
    int d0 = n0;
    if (headperm) { const int ja = n0 & 255, wc = ja >> 6, bj = (ja >> 5) & 1; d0 = (n0 - ja) + 128 * bj + 32 * wc; }
    const int c = lane & 7;
#pragma unroll
    for (int j = 0; j < 4; ++j) { const int n = (lane >> 3) + 8 * j; const LAS float* s = scr + (8 * c) * 33 + n;
        v4u o; o.x = pk2(s[0 * 33], s[1 * 33]); o.y = pk2(s[2 * 33], s[3 * 33]); o.z = pk2(s[4 * 33], s[5 * 33]); o.w = pk2(s[6 * 33], s[7 * 33]);
        *(v4u*)(WT + (size_t)(row_off + d0 + n) * K + k0 + 8 * c) = o; }
    asm volatile("s_waitcnt lgkmcnt(0)" ::: "memory");
}

__device__ __forceinline__ const float* pick_in(const Args& a, int i) {
    const float* p = a.in[2];
    switch (i) { case 3: p = a.in[3]; break; case 7: p = a.in[7]; break; case 8: p = a.in[8]; break; case 9: p = a.in[9]; break; case 11: p = a.in[11]; break; case 12: p = a.in[12]; break;
                 case 14: p = a.in[14]; break; case 15: p = a.in[15]; break; case 16: p = a.in[16]; break; case 17: p = a.in[17]; break; case 18: p = a.in[18]; break; case 19: p = a.in[19]; break; case 20: p = a.in[20]; break; default: break; }
    return p;
}
__device__ __forceinline__ void prologue_phase(const Frame& F, const Args& a) {
    unsigned char* ws = a.ws;
    int tid_ = threadIdx.x; asm volatile("" : "+v"(tid_));
    const int lane_ = tid_ & 63, wave_ = __builtin_amdgcn_readfirstlane(tid_ >> 6);
    LAS float* scr = (LAS float*)(F.lds + wave_ * 16384);
    const int gw = F.vcu * NWAVES + wave_, NGW = F.G * NWAVES;
    constexpr int I_IN = (D / 64) * (2 * D / 32), I_SQ = (D / 64) * (D / 32), I_KV = I_IN, I_UP = (D / 64) * (FF / 32), I_DN = (FF / 64) * (D / 32), I_PP = (PLE / 64) * (D / 32);
    constexpr int NITEMS = I_IN + I_SQ + I_SQ + I_KV + I_SQ + 2 * I_UP + 2 * I_DN + 2 * I_SQ + 2 * I_PP;
    for (int i = 4 * gw; i < (2 * M * PLE) / 512; i += 4 * NGW) {
        const f32x4* pr = (const f32x4*)(a.in[1] + (size_t)i * 512) + 2 * lane_;
        f32x4 x[8];
#pragma unroll
        for (int j = 0; j < 4; ++j) { x[2 * j] = __builtin_nontemporal_load(pr + 128 * j); x[2 * j + 1] = __builtin_nontemporal_load(pr + 128 * j + 1); }
#pragma unroll
        for (int j = 0; j < 4; ++j) { v4u o; o.x = pk2(x[2 * j].x, x[2 * j].y); o.y = pk2(x[2 * j].z, x[2 * j].w); o.z = pk2(x[2 * j + 1].x, x[2 * j + 1].y); o.w = pk2(x[2 * j + 1].z, x[2 * j + 1].w);
            *((v4u*)((bf16*)(ws + WS_PBF) + (size_t)(i + j) * 512) + lane_) = o; }
    }
    for (int it = gw; it < NITEMS; it += NGW) {
        int r = NITEMS - 1 - it, ii = 3, ig = 2, K = D, N = 2 * D, roff = 0; size_t woff = 0, dsto = WS_WIN; int goff = 0; bool hp = false, done = false;
        if (r < I_IN) { done = true; } else r -= I_IN;
        if (!done) { if (r < I_SQ) { ii = 7; ig = -1; N = D; dsto = WS_WOA; done = true; } else r -= I_SQ; }
        if (!done) { if (r < I_SQ) { ii = 12; ig = 11; N = D; dsto = WS_WQKV; hp = true; done = true; } else r -= I_SQ; }
        if (!done) { if (r < I_KV) { ii = 9; ig = 8; N = 2 * D; dsto = WS_WQKV; roff = D; hp = true; done = true; } else r -= I_KV; }
        if (!done) { if (r < I_SQ) { ii = 14; ig = -1; N = D; dsto = WS_WOB; done = true; } else r -= I_SQ; }
        if (!done) { if (r < 2 * I_UP) { const int l = r / I_UP; r -= l * I_UP; ii = 16; ig = 15; N = FF; woff = (size_t)l * D * FF; goff = l * D; dsto = WS_WUP + woff * 2; done = true; } else r -= 2 * I_UP; }
        if (!done) { if (r < 2 * I_DN) { const int l = r / I_DN; r -= l * I_DN; ii = 17; ig = -1; K = FF; N = D; woff = (size_t)l * D * FF; dsto = WS_WDN + woff * 2; done = true; } else r -= 2 * I_DN; }
        if (!done) { if (r < 2 * I_SQ) { const int l = r / I_SQ; r -= l * I_SQ; ii = 19; ig = 18; N = D; woff = (size_t)l * D * D; goff = l * D; dsto = WS_WG + woff * 2; done = true; } else r -= 2 * I_SQ; }
        if (!done) { const int l = r / I_PP; r -= l * I_PP; ii = 20; ig = -1; K = PLE; N = D; woff = (size_t)l * PLE * D; dsto = WS_WPP + woff * 2; }
        const float* Wp = pick_in(a, ii) + woff; const float* gp = (ig >= 0) ? pick_in(a, ig) + goff : nullptr;
        tr_item(Wp, K, N, gp, (bf16*)(ws + dsto), roff, hp, scr, r, lane_);
    }
    float* ssq0 = (float*)(ws + WS_SSQ) + (size_t)SQ_X0 * M * 16;
    for (int m = 2 * gw; m < M; m += 2 * NGW) {
        const f32x4* xr = (const f32x4*)(a.in[0] + (size_t)m * D) + lane_;
        f32x4 v[8]; float s0 = 0.f, s1 = 0.f;
#pragma unroll
        for (int j = 0; j < 8; ++j) v[j] = __builtin_nontemporal_load(xr + 64 * j);
#pragma unroll
        for (int j = 0; j < 4; ++j) { s0 += (v[j].x * v[j].x + v[j].y * v[j].y) + (v[j].z * v[j].z + v[j].w * v[j].w); s1 += (v[4 + j].x * v[4 + j].x + v[4 + j].y * v[4 + j].y) + (v[4 + j].z * v[4 + j].z + v[4 + j].w * v[4 + j].w); }
        s0 = wave_sum(s0); s1 = wave_sum(s1);
        unsigned long long* o8 = (unsigned long long*)((bf16*)(ws + WS_XB) + (size_t)m * D) + lane_;
#pragma unroll
        for (int j = 0; j < 8; ++j) o8[64 * j] = (unsigned long long)pk2(v[j].x, v[j].y) | ((unsigned long long)pk2(v[j].z, v[j].w) << 32);
        if (lane_ < 32) ssq0[(size_t)m * 16 + lane_] = (lane_ == 0) ? s0 : (lane_ == 16) ? s1 : 0.f;
    }
}

__device__ __forceinline__ void sgu_phase(const Frame& F, const Args& a) {
    unsigned char* ws = a.ws;
    const bf16* Z = (const bf16*)(ws + WS_BIG); bf16* Y = (bf16*)(ws + WS_BIG + 64 * MiB);
    const float* ssqv = (const float*)(ws + WS_SSQ) + (size_t)SQ_V * M * 16;
    const float* wsp = a.in[5]; const float* bsp = a.in[6]; const float* gv = a.in[4];
    constexpr int RS = 272;
    LAS unsigned char* WSL = F.lds; LAS unsigned char* VTL = F.lds + 128 * RS; LAS float* rsl = (LAS float*)(F.lds + 2 * 128 * RS);
    int tid_ = threadIdx.x; asm volatile("" : "+v"(tid_));
    const int tid = tid_, lane = tid & 63, w = __builtin_amdgcn_readfirstlane(tid >> 6), fr = lane & 15, fq = lane >> 4;
    for (int unit = F.vcu; unit < (M / CHUNK) * NGRP; unit += F.G) {
        const int c = unit >> 3, g = unit & 7, rowb = c * CHUNK;
        if (tid < 128) { const f32x4* sp = (const f32x4*)(ssqv + (size_t)(rowb + tid) * 16); const f32x4 s0 = sp[0], s1 = sp[1], s2 = sp[2], s3 = sp[3];
            const float s = ((s0[0] + s0[1]) + (s0[2] + s0[3])) + ((s1[0] + s1[1]) + (s1[2] + s1[3])) + ((s2[0] + s2[1]) + (s2[2] + s2[3])) + ((s3[0] + s3[1]) + (s3[2] + s3[3]));
            rsl[tid] = __builtin_amdgcn_rsqf(s * (1.0f / 1024.0f) + 1e-6f); }
        __syncthreads();
#pragma unroll
        for (int i = 0; i < 8; ++i) { const int idx = i * 512 + tid, t = idx >> 5, s4 = idx & 31;
            const f32x4 wv = *(const f32x4*)(wsp + (size_t)g * 16384 + t * 128 + 4 * s4); const f32x4 r = *(const LAS f32x4*)(rsl + 4 * s4);
            float e[4];
#pragma unroll
            for (int k = 0; k < 4; ++k) e[k] = (4 * s4 + k <= t) ? wv[k] * r[k] : 0.f;
            v2u o; o.x = pk2(e[0], e[1]); o.y = pk2(e[2], e[3]);
            *(LAS v2u*)(WSL + t * RS + s4 * 8) = o; }
#pragma unroll
        for (int i = 0; i < 4; ++i) { const int idx = i * 512 + tid, dc = idx & 15, s = idx >> 4;
            const v4u pv = __builtin_nontemporal_load((const v4u*)(Z + (size_t)(rowb + s) * 2048 + 1024 + g * 128 + dc * 8));
#pragma unroll
            for (int j = 0; j < 8; ++j) { const unsigned hw = (pv[j >> 1] >> (16 * (j & 1))) & 0xffffu; *(LAS unsigned short*)(VTL + (dc * 8 + j) * RS + ((((s >> 3) ^ dc) << 3) | (s & 7)) * 2) = (unsigned short)hw; } }
        __syncthreads();
        const int t0 = 16 * w, nks = (w >> 1) + 1;
        bf16x8 wf[4];
#pragma unroll
        for (int ks = 0; ks < 4; ++ks) wf[ks] = (ks < nks) ? *(const LAS bf16x8*)(WSL + (t0 + fr) * RS + (32 * ks + 8 * fq) * 2) : (bf16x8){0, 0, 0, 0, 0, 0, 0, 0};
        f32x4 acc[8];
#pragma unroll
        for (int n = 0; n < 8; ++n) { acc[n] = (f32x4){0.f, 0.f, 0.f, 0.f};
#pragma unroll
            for (int ks = 0; ks < 4; ++ks) if (ks < nks) { const bf16x8 vf = *(const LAS bf16x8*)(VTL + (16 * n + fr) * RS + (((4 * ks + fq) ^ (2 * n + (fr >> 3))) << 4));
                acc[n] = __builtin_amdgcn_mfma_f32_16x16x32_bf16(vf, wf[ks], acc[n], 0, 0, 0); } }
        const int t = t0 + fr, row = rowb + t; const float bias = bsp[g * 128 + t];
#pragma unroll
        for (int n = 0; n < 8; ++n) { const int col = g * 128 + 16 * n + 4 * fq;
            const f32x4 gg = *(const f32x4*)(gv + col); const v2u uu = *(const v2u*)(Z + (size_t)row * 2048 + col);
            const float y0 = __uint_as_float(uu.x << 16) * (gg[0] * acc[n][0] + bias), y1 = __uint_as_float(uu.x & 0xffff0000u) * (gg[1] * acc[n][1] + bias);
            const float y2 = __uint_as_float(uu.y << 16) * (gg[2] * acc[n][2] + bias), y3 = __uint_as_float(uu.y & 0xffff0000u) * (gg[3] * acc[n][3] + bias);
            v2u o; o.x = pk2(y0, y1); o.y = pk2(y2, y3);
            if (unit + F.G >= (M / CHUNK) * NGRP) pg8::st8_wt(Y + (size_t)row * 1024 + col, o); else *(v2u*)(Y + (size_t)row * 1024 + col) = o; }
        __syncthreads();
    }
}

__device__ __forceinline__ int crow(int r, int hi) { return (r & 3) + 8 * (r >> 2) + 4 * hi; }
__device__ __forceinline__ unsigned cvtpk_s(float lo, float hi) { typedef float f2 __attribute__((ext_vector_type(2))); typedef __bf16 b2 __attribute__((ext_vector_type(2))); f2 v = {lo, hi}; b2 b = __builtin_convertvector(v, b2); return __builtin_bit_cast(unsigned, b); }
__device__ __forceinline__ unsigned cvtpk_h(float lo, float hi) { typedef float f2 __attribute__((ext_vector_type(2))); typedef _Float16 h2 __attribute__((ext_vector_type(2))); f2 v = {lo, hi}; h2 h = __builtin_convertvector(v, h2); return __builtin_bit_cast(unsigned, h); }
constexpr int AT_K = 0, AT_V = 40960, AT_OST = 90112, AT_SLOT = 8192, AT_FLAG = 122880;
constexpr float ATT_CUT = 60.0f;
struct PFrag { bf16x8 a0, a1, a2, a3; };
__device__ __forceinline__ PFrag attn_front(const LAS unsigned char* kb, const bf16x8 (&qr)[4], f32x16& cvn, const f16x8 Ts0, const f16x8 Ts1, const f16x8 ONES, const bool needmask, const int kmin, const int tq, const int hi) {
    f32x16 p0 = f32x16{}, p1 = f32x16{};
#pragma unroll
    for (int d0 = 0; d0 < 4; ++d0) { const bf16x8 b0 = *(const LAS bf16x8*)(kb + d0 * 2048), b1 = *(const LAS bf16x8*)(kb + d0 * 2048 + 512);
        p0 = __builtin_amdgcn_mfma_f32_32x32x16_bf16(b0, qr[d0], p0, 0, 0, 0); p1 = __builtin_amdgcn_mfma_f32_32x32x16_bf16(b1, qr[d0], p1, 0, 0, 0); }
    f32x16 g0, g1;
#pragma unroll
    for (int r = 0; r < 16; ++r) { g0[r] = __builtin_amdgcn_logf(1.0f + __builtin_amdgcn_exp2f(p0[r])); g1[r] = __builtin_amdgcn_logf(1.0f + __builtin_amdgcn_exp2f(p1[r])); }
    if (needmask) {
#pragma unroll
        for (int r = 0; r < 16; ++r) { const int kv = kmin + crow(r, hi); if (kv >= tq) { g0[r] = 0.f; p0[r] = -INFINITY; } if (kv + 32 >= tq) { g1[r] = 0.f; p1[r] = -INFINITY; } }
    }
    unsigned n0[8], n1[8];
#pragma unroll
    for (int i = 0; i < 8; ++i) { n0[i] = cvtpk_h(-g0[2 * i], -g0[2 * i + 1]); n1[i] = cvtpk_h(-g1[2 * i], -g1[2 * i + 1]); }
    const f16x8 nl00 = __builtin_bit_cast(f16x8, (v4u){n0[0], n0[1], n0[2], n0[3]}), nl01 = __builtin_bit_cast(f16x8, (v4u){n0[4], n0[5], n0[6], n0[7]});
    const f16x8 nl10 = __builtin_bit_cast(f16x8, (v4u){n1[0], n1[1], n1[2], n1[3]}), nl11 = __builtin_bit_cast(f16x8, (v4u){n1[4], n1[5], n1[6], n1[7]});
    f32x16 U = __builtin_amdgcn_mfma_f32_32x32x16_f16(ONES, nl10, cvn, 0, 0, 0); U = __builtin_amdgcn_mfma_f32_32x32x16_f16(ONES, nl11, U, 0, 0, 0);
    f32x16 X1 = p1 + cvn;
    X1 = __builtin_amdgcn_mfma_f32_32x32x16_f16(Ts0, nl10, X1, 0, 0, 0); X1 = __builtin_amdgcn_mfma_f32_32x32x16_f16(Ts1, nl11, X1, 0, 0, 0);
    f32x16 X0 = p0 + U;
    X0 = __builtin_amdgcn_mfma_f32_32x32x16_f16(Ts0, nl00, X0, 0, 0, 0); X0 = __builtin_amdgcn_mfma_f32_32x32x16_f16(Ts1, nl01, X0, 0, 0, 0);
    cvn = __builtin_amdgcn_mfma_f32_32x32x16_f16(ONES, nl00, U, 0, 0, 0); cvn = __builtin_amdgcn_mfma_f32_32x32x16_f16(ONES, nl01, cvn, 0, 0, 0);
    unsigned pw[16];
#pragma unroll
    for (int i = 0; i < 8; ++i) { pw[i] = cvtpk_s(__builtin_amdgcn_exp2f(X0[2 * i]), __builtin_amdgcn_exp2f(X0[2 * i + 1])); pw[8 + i] = cvtpk_s(__builtin_amdgcn_exp2f(X1[2 * i]), __builtin_amdgcn_exp2f(X1[2 * i + 1])); }
    PFrag P;
    P.a0 = __builtin_bit_cast(bf16x8, (v4u){pw[0], pw[1], pw[2], pw[3]}); P.a1 = __builtin_bit_cast(bf16x8, (v4u){pw[4], pw[5], pw[6], pw[7]});
    P.a2 = __builtin_bit_cast(bf16x8, (v4u){pw[8], pw[9], pw[10], pw[11]}); P.a3 = __builtin_bit_cast(bf16x8, (v4u){pw[12], pw[13], pw[14], pw[15]});
    return P;
}
__device__ __forceinline__ void attn_pv(f32x16 (&o)[2], const int vb, const PFrag& P) {
#pragma unroll
    for (int d0 = 0; d0 < 2; ++d0) { s16x4 lo4[4], hi4[4];
#pragma unroll
        for (int ks = 0; ks < 4; ++ks) {
            asm volatile("ds_read_b64_tr_b16 %0,%1 offset:%c2" : "=&v"(lo4[ks]) : "v"(vb), "i"(d0 * 4096 + ks * 1024) : "memory");
            asm volatile("ds_read_b64_tr_b16 %0,%1 offset:%c2" : "=&v"(hi4[ks]) : "v"(vb), "i"(d0 * 4096 + ks * 1024 + 512) : "memory"); }
        asm volatile("s_waitcnt lgkmcnt(0)" ::: "memory"); __builtin_amdgcn_sched_barrier(0);
#define PKV(k) (bf16x8){lo4[k][0], lo4[k][1], lo4[k][2], lo4[k][3], hi4[k][0], hi4[k][1], hi4[k][2], hi4[k][3]}
        o[d0] = __builtin_amdgcn_mfma_f32_32x32x16_bf16(P.a0, PKV(0), o[d0], 0, 0, 0);
        o[d0] = __builtin_amdgcn_mfma_f32_32x32x16_bf16(P.a1, PKV(1), o[d0], 0, 0, 0);
        o[d0] = __builtin_amdgcn_mfma_f32_32x32x16_bf16(P.a2, PKV(2), o[d0], 0, 0, 0);
        o[d0] = __builtin_amdgcn_mfma_f32_32x32x16_bf16(P.a3, PKV(3), o[d0], 0, 0, 0);
#undef PKV
    }
}

__device__ __forceinline__ void attn_unit(int b, int h, int qb, const bf16* Q, const bf16* K, const bf16* V, bf16* O, LAS unsigned char* lds, bool wt) {
    int tid_ = threadIdx.x; asm volatile("" : "+v"(tid_));
    const int tid = tid_, lane = tid & 63, r32 = lane & 31, hi = lane >> 5; const int wid = __builtin_amdgcn_readfirstlane(tid >> 6);
    const long rowbase = (long)b * SEQ; const int q0 = qb * 256;
    const bf16* Qw = Q + (rowbase + q0 + wid * 32) * D + h * HD;
    const bf16* ksrc = K + (rowbase + lane) * D + h * HD + wid * 8;
    const bf16* vsrc = V + (rowbase + 16 * (wid & 3) + (lane >> 2)) * D + h * HD + (wid >> 2) * 32 + (lane & 3) * 8;
    const int sdst = wid * 1024 + lane * 16;
    const unsigned lds0 = (unsigned)(uintptr_t)lds;
    const int vb0 = (int)(lds0 + AT_V) + ((lane >> 4) & 1) * 32 + (lane & 3) * 8 + (4 * hi + ((lane & 15) >> 2)) * 64;
    const LAS unsigned char* kb0 = lds + AT_K + hi * 1024 + r32 * 16;
    bf16x8 qr[4];
#pragma unroll
    for (int d0 = 0; d0 < 4; ++d0) qr[d0] = *(const bf16x8*)(Qw + (long)r32 * D + d0 * 16 + hi * 8);
    const int NT = 4 * (qb + 1);
    f32x16 o[2]; o[0] = f32x16{}; o[1] = f32x16{};
    f32x16 cvn = f32x16{};
    f16x8 Ts0, Ts1, ONES;
#pragma unroll
    for (int jj = 0; jj < 8; ++jj) { const int k0 = 8 * (jj >> 2) + 4 * hi + (jj & 3); Ts0[jj] = (k0 >= r32) ? (_Float16)1.0f : (_Float16)0.0f; Ts1[jj] = (16 + k0 >= r32) ? (_Float16)1.0f : (_Float16)0.0f; ONES[jj] = (_Float16)1.0f; }
    const int tq = wid * 32 + r32;
#pragma unroll
    for (int j = 0; j < 4; ++j) { const int t = NT - 4 + j; const v4u kk = *(const v4u*)(ksrc + (long)t * 64 * D), vv = *(const v4u*)(vsrc + (long)t * 64 * D);
        *(LAS v4u*)(lds + AT_K + (t % 5) * AT_SLOT + sdst) = kk; *(LAS v4u*)(lds + AT_V + (t % 6) * AT_SLOT + sdst) = vv; }
    asm volatile("" : "+v"(qr[0]), "+v"(qr[1]), "+v"(qr[2]), "+v"(qr[3]));
    __syncthreads();
    LAS unsigned* flg = (LAS unsigned*)(lds + AT_FLAG);
    const int dw = NT - 4 + (wid >> 1);
    bool wdone = false;
    v4u kreg, vreg;
    if (wid < 4) {
        for (int it = 0; it < NT; ++it) {
            const int tn = NT - 5 - it, t = dw - it;
            if (tn >= 0) { kreg = *(const v4u*)(ksrc + (long)tn * 64 * D); vreg = *(const v4u*)(vsrc + (long)tn * 64 * D); }
            if (t < 0) wdone = true;
            if (!wdone) {
                const int kmin = 64 * (t - (NT - 4));
                const PFrag P = attn_front(kb0 + (t % 5) * AT_SLOT, qr, cvn, Ts0, Ts1, ONES, kmin + 63 >= wid * 32, kmin, tq, hi);
                attn_pv(o, vb0 + (t % 6) * AT_SLOT, P);
                wdone = __all(cvn[0] < -ATT_CUT);
            }
            if (tn >= 0) { *(LAS v4u*)(lds + AT_K + (tn % 5) * AT_SLOT + sdst) = kreg; *(LAS v4u*)(lds + AT_V + (tn % 6) * AT_SLOT + sdst) = vreg; }
            if (lane == 0) flg[(it & 1) * 8 + wid] = wdone ? 1u : 0u;
            __syncthreads();
            { const v4u f0 = *(const LAS v4u*)(flg + (it & 1) * 8), f1 = *(const LAS v4u*)(flg + (it & 1) * 8 + 4);
              if ((f0.x & f0.y & f0.z & f0.w & f1.x & f1.y & f1.z & f1.w) != 0u) break; }
        }
    } else {
        PFrag Pd; Pd.a0 = Pd.a1 = Pd.a2 = Pd.a3 = (bf16x8){0, 0, 0, 0, 0, 0, 0, 0}; bool have = false; int vprev = 0;
        for (int it = 0; it < NT; ++it) {
            const int tn = NT - 5 - it, t = dw - it;
            if (tn >= 0) { kreg = *(const v4u*)(ksrc + (long)tn * 64 * D); vreg = *(const v4u*)(vsrc + (long)tn * 64 * D); }
            if (have) { attn_pv(o, vb0 + vprev, Pd); have = false; }
            if (t < 0) wdone = true;
            if (!wdone) {
                const int kmin = 64 * (t - (NT - 4));
                Pd = attn_front(kb0 + (t % 5) * AT_SLOT, qr, cvn, Ts0, Ts1, ONES, kmin + 63 >= wid * 32, kmin, tq, hi); have = true; vprev = (t % 6) * AT_SLOT;
                wdone = __all(cvn[0] < -ATT_CUT);
            }
            if (tn >= 0) { *(LAS v4u*)(lds + AT_K + (tn % 5) * AT_SLOT + sdst) = kreg; *(LAS v4u*)(lds + AT_V + (tn % 6) * AT_SLOT + sdst) = vreg; }
            if (lane == 0) flg[(it & 1) * 8 + wid] = wdone ? 1u : 0u;
            __syncthreads();
            { const v4u f0 = *(const LAS v4u*)(flg + (it & 1) * 8), f1 = *(const LAS v4u*)(flg + (it & 1) * 8 + 4);
              if ((f0.x & f0.y & f0.z & f0.w & f1.x & f1.y & f1.z & f1.w) != 0u) break; }
        }
        if (have) attn_pv(o, vb0 + vprev, Pd);
    }
    bf16* Ow = O + (rowbase + q0 + wid * 32) * D + h * HD;
    LAS bf16* stg = (LAS bf16*)(lds + AT_OST + wid * 4096);
#pragma unroll
    for (int r = 0; r < 16; ++r) { const int orow = crow(r, hi);
#pragma unroll
        for (int d0 = 0; d0 < 2; ++d0) stg[orow * 64 + d0 * 32 + r32] = (bf16)f2bf(o[d0][r]); }
    asm volatile("s_waitcnt lgkmcnt(0)" ::: "memory");
#pragma unroll
    for (int i = 0; i < 4; ++i) { const int row = i * 8 + (lane >> 3), ch = lane & 7; const v4u v = *(const LAS v4u*)(stg + row * 64 + ch * 8); if (wt) pg8::st16_wt(Ow + (long)row * D + ch * 8, v); else *(v4u*)(Ow + (long)row * D + ch * 8) = v; }
    asm volatile("s_waitcnt lgkmcnt(0)" ::: "memory");
    __syncthreads();
}

__device__ __forceinline__ void attn_phase(const Frame& F, const Args& a) {
    unsigned char* ws = a.ws;
    const bf16* Q = (const bf16*)(ws + WS_BIG); const bf16* K = (const bf16*)(ws + WS_BIG + 32 * MiB); const bf16* V = (const bf16*)(ws + WS_BIG + 64 * MiB); bf16* O = (bf16*)(ws + WS_BIG);
    const int nslots = (BATCH * H * 2);
    for (int sv = F.vcu; sv < nslots; sv += F.G) {
        const int bh = sv >> 1, odd = sv & 1;
#pragma unroll 1
        for (int i = 0; i < 4; ++i) { const int base = (i == 0) ? 0 : (i == 1) ? 7 : (i == 2) ? 2 : 5; const int qb = odd ? ((i & 1) ? base - 1 : base + 1) : base;
            attn_unit(bh / H, bh % H, qb, Q, K, V, O, F.lds, i == 3 && sv + F.G >= nslots); }
    }
}

#define XB_TMO      128
#define XB_XCNT(j)  (256  + 64 * (j))
#define XB_XSUB(j)  (1280 + 64 * (j))
#define XB_XGEN(j)  (2304 + 64 * (j))
#define XB_TOP      3328
#define XB_TOPGEN   3392
#define XCD_BAR_WORDS 3456
#define XB_SPIN_CAP (1u << 18)

__device__ __forceinline__ unsigned xb_ld(unsigned* p)              { return __hip_atomic_load(p, __ATOMIC_RELAXED, __HIP_MEMORY_SCOPE_AGENT); }
__device__ __forceinline__ unsigned xb_add(unsigned* p, unsigned v) { return __hip_atomic_fetch_add(p, v, __ATOMIC_RELAXED, __HIP_MEMORY_SCOPE_AGENT); }
__device__ __forceinline__ unsigned xb_xcc_id() { return (unsigned)__builtin_amdgcn_s_getreg((3 << 11) | 20) & 0xFu; }
#define XB_SPIN(cond, bar) do { unsigned _sp = 0; while (cond) { \
    if ((++_sp & 255u) == 0u) { if (xb_ld(&(bar)[XB_TMO])) break; if (_sp > XB_SPIN_CAP) { atomicAdd(&(bar)[XB_TMO], 1u); break; } } } } while (0)

struct XcdBarrier {
    unsigned* bar; unsigned x;
    volatile LAS unsigned* st;
};

__device__ __forceinline__ XcdBarrier xcd_barrier_post(unsigned* bar, volatile LAS unsigned* st) {
    XcdBarrier b; b.bar = bar; b.x = xb_xcc_id(); b.st = st;
    if (threadIdx.x == 0) (void)xb_add(&bar[XB_XCNT(b.x)], 1u);
    return b;
}
__device__ __forceinline__ void xcd_barrier_complete(unsigned* bar, unsigned x, unsigned& nloc, unsigned& nx) {
    const unsigned G = gridDim.x * gridDim.y * gridDim.z;
    unsigned sum, cnt, mine, sp = 0u;
    for (;;) {
        sum = 0u; cnt = 0u; mine = 0u;
#pragma unroll
        for (unsigned j = 0; j < 16; ++j) { const unsigned c = xb_ld(&bar[XB_XCNT(j)]); sum += c; cnt += (c > 0u) ? 1u : 0u; mine = (j == x) ? c : mine; }
        if (sum == G) break;
        __builtin_amdgcn_s_sleep(1);
        if ((++sp & 255u) == 0u) { if (xb_ld(&bar[XB_TMO])) break; if (sp > XB_SPIN_CAP) { atomicAdd(&bar[XB_TMO], 1u); break; } }
    }
    nloc = mine > 0u ? mine : 1u; nx = cnt > 0u ? cnt : 1u;
}

__device__ __forceinline__ void xcd_barrier(const XcdBarrier& b) {
    asm volatile("s_waitcnt vmcnt(0)" ::: "memory");
    __syncthreads();
    if (threadIdx.x == 0) {
        unsigned* bar = b.bar;
        __builtin_amdgcn_s_waitcnt(0);
        unsigned nloc = b.st[0], nx = b.st[1];
        if (nloc == 0u) { xcd_barrier_complete(bar, b.x, nloc, nx); b.st[0] = nloc; b.st[1] = nx; }
        const unsigned old = xb_add(&bar[XB_XSUB(b.x)], 1u);
        const unsigned gen = old / nloc;
        if (old + 1u == (gen + 1u) * nloc) {
            __builtin_amdgcn_fence(__ATOMIC_RELEASE, "agent");
            asm volatile("s_waitcnt vmcnt(0)" ::: "memory");
            const unsigned og = xb_add(&bar[XB_TOP], 1u);
            const unsigned tg = og / nx;
            if (og + 1u == (tg + 1u) * nx) xb_add(&bar[XB_TOPGEN], 1u);
            else XB_SPIN(xb_ld(&bar[XB_TOPGEN]) == tg, bar);
            __builtin_amdgcn_fence(__ATOMIC_ACQUIRE, "agent");
            xb_add(&bar[XB_XGEN(b.x)], 1u);
            asm volatile("s_waitcnt vmcnt(0)" ::: "memory");
        } else {
            XB_SPIN(xb_ld(&bar[XB_XGEN(b.x)]) == gen, bar);
            __builtin_amdgcn_fence(__ATOMIC_ACQUIRE, "agent");
            asm volatile("s_waitcnt vmcnt(0)" ::: "memory");
        }
    }
    __syncthreads();
}

enum { ST_PRO = 0, ST_WIN, ST_SGU, ST_WOA, ST_UP0, ST_DN0, ST_PP0, ST_GATE0, ST_QKV, ST_ATT, ST_WOB, ST_UP1, ST_DN1, ST_PP1, ST_GATE1, ST_N };
__host__ __device__ __forceinline__ bool sync_after(int st) { return !(st == ST_PP0 || st == ST_PP1 || st == ST_GATE1); }

template <int ST> __device__ __forceinline__ void run_step(const Args& args, const Frame& F, unsigned char* ws) {
    asm volatile("" : "+s"(ws));
    float* ssq = (float*)(ws + WS_SSQ);
#define SSQ(i) (ssq + (size_t)(i) * M * 16)
    bf16* XB = (bf16*)(ws + WS_XB); bf16* BIG = (bf16*)(ws + WS_BIG); bf16* XB3 = (bf16*)(ws + WS_BIG + 96 * MiB);
    typedef pg8::EpiResT<false> ResN; typedef pg8::EpiResT<true> ResF;
    constexpr int l = (ST >= ST_WOB) ? 1 : 0;
    if constexpr (ST == ST_PRO) prologue_phase(F, args);
    else if constexpr (ST == ST_SGU) sgu_phase(F, args);
    else if constexpr (ST == ST_ATT) attn_phase(F, args);
    else if constexpr (ST == ST_WIN) { const pg8::Gemm g{XB, (const bf16*)(ws + WS_WIN), M, 2 * D, D}; const pg8::EpiAct E{BIG, 2 * D, SSQ(SQ_X0), SSQ(SQ_V), 1};
        pg8::StaticOrder S; S.init(g.M, g.N, F.G, (int)blockIdx.x); pg8::gemm_phase<pg8::EpiAct, pg8::StaticOrder, true, true>(F.lds, g, S, E); }
    else if constexpr (ST == ST_WOA) { const pg8::Gemm g{(const bf16*)(ws + WS_BIG + 64 * MiB), (const bf16*)(ws + WS_WOA), M, D, D}; const ResN E{XB, XB, nullptr, SSQ(SQ_X1), nullptr, nullptr, 0};
        pg8::StaticOrder S; S.init(g.M, g.N, F.G, (int)blockIdx.x); pg8::gemm_phase<ResN, pg8::StaticOrder, true, true>(F.lds, g, S, E); }
    else if constexpr (ST == ST_UP0 || ST == ST_UP1) { const pg8::Gemm g{XB, (const bf16*)(ws + WS_WUP) + (size_t)l * D * FF, M, FF, D}; const pg8::EpiAct E{BIG, FF, SSQ(l ? SQ_X4 : SQ_X1), nullptr, 2};
        pg8::StaticOrder S; S.init(g.M, g.N, F.G, (int)blockIdx.x); pg8::gemm_phase<pg8::EpiAct, pg8::StaticOrder, true, true>(F.lds, g, S, E); }
    else if constexpr (ST == ST_DN0 || ST == ST_DN1) { const pg8::Gemm g{BIG, (const bf16*)(ws + WS_WDN) + (size_t)l * D * FF, M, D, FF}; const ResN E{XB, XB, nullptr, SSQ(l ? SQ_X5 : SQ_X2), nullptr, nullptr, 0};
        pg8::StaticOrder S; S.init(g.M, g.N, F.G, (int)blockIdx.x); pg8::gemm_phase<ResN, pg8::StaticOrder, true, true>(F.lds, g, S, E); }
    else if constexpr (ST == ST_PP0 || ST == ST_PP1) { const pg8::Gemm g{(const bf16*)(ws + WS_PBF) + (size_t)l * M * PLE, (const bf16*)(ws + WS_WPP) + (size_t)l * PLE * D, M, D, PLE}; const pg8::EpiAct E{BIG, D, nullptr, nullptr, 0};
        pg8::StaticOrder S; S.init(g.M, g.N, F.G, (int)blockIdx.x); pg8::gemm_phase<pg8::EpiAct, pg8::StaticOrder, true, true>(F.lds, g, S, E); }
    else if constexpr (ST == ST_GATE0) { const pg8::Gemm g{XB, (const bf16*)(ws + WS_WG), M, D, D}; const ResN E{XB, XB3, nullptr, SSQ(SQ_X3), SSQ(SQ_X2), BIG, 1};
        pg8::StaticOrder S; S.init(g.M, g.N, F.G, (int)blockIdx.x); pg8::gemm_phase<ResN, pg8::StaticOrder, true, true>(F.lds, g, S, E); }
    else if constexpr (ST == ST_GATE1) { const pg8::Gemm g{XB, (const bf16*)(ws + WS_WG) + (size_t)D * D, M, D, D}; const ResF E{XB, nullptr, args.out, nullptr, SSQ(SQ_X5), BIG, 1};
        pg8::StaticOrder S; S.init(g.M, g.N, F.G, (int)blockIdx.x); pg8::gemm_phase<ResF, pg8::StaticOrder, true, true>(F.lds, g, S, E); }
    else if constexpr (ST == ST_QKV) { const pg8::Gemm g{XB3, (const bf16*)(ws + WS_WQKV), M, 3 * D, D}; const pg8::EpiQKV E{BIG, (size_t)M * D, SSQ(SQ_X3), args.in[13], args.in[10]};
        pg8::StaticOrder S; S.init(g.M, g.N, F.G, (int)blockIdx.x); pg8::gemm_phase<pg8::EpiQKV, pg8::StaticOrder, true, true>(F.lds, g, S, E); }
    else if constexpr (ST == ST_WOB) { const pg8::Gemm g{BIG, (const bf16*)(ws + WS_WOB), M, D, D}; const ResN E{XB3, XB, nullptr, SSQ(SQ_X4), nullptr, nullptr, 0};
        pg8::StaticOrder S; S.init(g.M, g.N, F.G, (int)blockIdx.x); pg8::gemm_phase<ResN, pg8::StaticOrder, true, true>(F.lds, g, S, E); }
#undef SSQ
}

__global__ void __launch_bounds__(NWAVES * 64, 2) yoco_fwd(Args args) {
    extern __shared__ __attribute__((aligned(16))) unsigned char lds[];
    cg::grid_group grid = cg::this_grid();
    Frame F; F.lds = (LAS unsigned char*)lds;
    F.G = gridDim.x; { const int bx = blockIdx.x; F.vcu = (F.G % 8 == 0) ? (bx % 8) * (F.G / 8) + bx / 8 : bx; }
    unsigned char* ws = args.ws;
    volatile LAS unsigned* MISC = (volatile LAS unsigned*)(F.lds + 131072 + 320);
    if (threadIdx.x < 32) MISC[threadIdx.x] = 0u;
    __syncthreads();
    XcdBarrier bar = xcd_barrier_post((unsigned*)(ws + WS_CTL) + 4096, MISC + 8);
#define STEP(k) do { if (args.lo <= (k) && (k) < args.hi) { run_step<(k)>(args, F, ws); \
        if ((k) + 1 < args.hi && sync_after(k)) { if (args.hi > 1000) grid.sync(); else xcd_barrier(bar); } else __syncthreads(); } } while (0)
    STEP(0); STEP(1); STEP(2); STEP(3); STEP(4); STEP(5); STEP(6); STEP(7); STEP(8); STEP(9); STEP(10); STEP(11); STEP(12); STEP(13); STEP(14);
#undef STEP
    static_assert(ST_N == 15, "the STEP list covers every step");
}

extern "C" void kernel_launch(void* const* d_in, const int* in_sizes, int n_in, void* d_out, int out_size, void* d_ws, size_t ws_size, hipStream_t stream) {
    static int grid = 0;
    if (grid == 0) {
        if (n_in != 21 || in_sizes[0] != M * D || out_size != M * D || ws_size < WS_END) { fprintf(stderr, "kernel_launch: unexpected shapes (n_in %d, in0 %d, out %d, ws %zu)\n", n_in, n_in > 0 ? in_sizes[0] : -1, out_size, ws_size); grid = -1; return; }
        int dev = 0, cus = 0, per_cu = 0;
        if (hipGetDevice(&dev) != hipSuccess || hipDeviceGetAttribute(&cus, hipDeviceAttributeMultiprocessorCount, dev) != hipSuccess) { grid = -1; return; }
        if (hipFuncSetAttribute((const void*)yoco_fwd, hipFuncAttributeMaxDynamicSharedMemorySize, LDS_BYTES) != hipSuccess) { fprintf(stderr, "kernel_launch: hipFuncSetAttribute failed\n"); grid = -1; return; }
        if (hipOccupancyMaxActiveBlocksPerMultiprocessor(&per_cu, (const void*)yoco_fwd, NWAVES * 64, LDS_BYTES) != hipSuccess || per_cu < 1) { fprintf(stderr, "kernel_launch: occupancy query says %d blocks per CU\n", per_cu); (void)hipGetLastError(); grid = -1; return; }
        grid = cus;
    }
    if (grid < 0) return;
    if (hipMemsetAsync((char*)d_ws + WS_CTL, 0, 65536, stream) != hipSuccess) { fprintf(stderr, "kernel_launch: hipMemsetAsync failed\n"); return; }
    Args a{};
    for (int i = 0; i < 21; ++i) a.in[i] = (const float*)d_in[i];
    a.out = (float*)d_out; a.ws = (unsigned char*)d_ws;
#if MK_SINGLE
    a.lo = 0; a.hi = ST_N;
    void* params[] = {&a};
    hipError_t e = hipLaunchCooperativeKernel((const void*)yoco_fwd, dim3(grid), dim3(NWAVES * 64), params, LDS_BYTES, stream);
    if (e != hipSuccess) fprintf(stderr, "kernel_launch: cooperative launch failed: %s (grid %d)\n", hipGetErrorString(e), grid);
#else
    int lo = 0;
    for (int st = 0; st < ST_N; ++st) {
        if (sync_after(st) || st == ST_N - 1) {
            a.lo = lo; a.hi = st + 1; lo = st + 1;
            void* params[] = {&a};
            hipError_t e = hipLaunchCooperativeKernel((const void*)yoco_fwd, dim3(grid), dim3(NWAVES * 64), params, LDS_BYTES, stream);
            if (e != hipSuccess) { fprintf(stderr, "kernel_launch: launch of steps [%d,%d) failed: %s\n", a.lo, a.hi, hipGetErrorString(e)); break; }
        }
    }
#endif
}
```

```cpp
#include <hip/hip_runtime.h>
#include <hip/hip_cooperative_groups.h>
#include <cstdio>
#include <cstdint>
#include <cmath>
namespace cg = cooperative_groups;
namespace pg8 {
#define PG8_LAS __attribute__((address_space(3)))
typedef unsigned short bf16_t;
typedef short bf16x8 __attribute__((ext_vector_type(8)));
typedef float f32x4 __attribute__((ext_vector_type(4)));
typedef unsigned u32x4 __attribute__((ext_vector_type(4)));
typedef unsigned u32x2 __attribute__((ext_vector_type(2)));
constexpr int BM = 256, BK = 64, HALF = 128, HTB = HALF * BK * 2  , STAGE_BYTES = 8 * HTB, NXCD = 8, WGM = 8;

__host__ __device__ __forceinline__ int lds_byte(int r, int c) { const int st = (r >> 4) * 2 + (c >> 5), rr = r & 15, cc = c & 31, ob = rr * 64 + cc * 2; return st * 1024 + (ob ^ (((ob >> 9) & 1) << 5)); }
__host__ __device__ __forceinline__ void stage_rc(int b, int& R, int& C) { const int st = b / 1024, sb = b % 1024, swz = sb ^ (((sb >> 9) & 1) << 5); R = (st >> 1) * 16 + swz / 64; C = (st & 1) * 32 + (swz % 64) / 2; }
__host__ __device__ __forceinline__ int perm32(int rho) { const int n = rho >> 4, i = rho & 15; return 8 * (i >> 2) + 4 * n + (i & 3); }

struct Unit { int pm, pn; };
struct Gemm { const bf16_t* A; const bf16_t* Bt; int M, N, K; };

struct StaticOrder {
    int nM, nN, nwg, G, c;
    __host__ __device__ void init(int M, int N, int G_, int c_) { nM = M / BM; nN = N / BM; nwg = nM * nN; G = G_; c = c_; }
    __host__ __device__ bool next(int i, Unit& u) const {
        const long L = (long)i * G + c; if (L >= nwg) return false;
        int wgid = (int)L; { const int q = nwg / NXCD, r = nwg % NXCD, xcd = wgid % NXCD, off = wgid / NXCD; wgid = (xcd < r ? xcd * (q + 1) : r * (q + 1) + (xcd - r) * q) + off; }
        const int nig = WGM * nN, gid = wgid / nig, fm = gid * WGM, gsz = (nM - fm) < WGM ? (nM - fm) : WGM;
        u.pm = fm + ((wgid % nig) % gsz); u.pn = (wgid % nig) / gsz; return true;
    }
    __device__ __forceinline__ void a_ready(const Unit&) const {}
    __device__ __forceinline__ void done(const Unit&) const {}
};
__device__ __forceinline__ unsigned cvt_pk_bf16(float lo, float hi) { unsigned r; asm volatile("v_cvt_pk_bf16_f32 %0, %1, %2" : "=v"(r) : "v"(lo), "v"(hi)); return r; }
typedef float f32x2 __attribute__((ext_vector_type(2)));
__device__ __forceinline__ void rs8_issue(f32x4 (&v)[2][4], const float* ssq, int row0, int fq) {
#pragma unroll
    for (int ai = 0; ai < 2; ++ai)
#pragma unroll
        for (int m = 0; m < 4; ++m) v[ai][m] = *(const f32x4*)(ssq + (size_t)(row0 + ai * HALF + m * 16) * 16 + 4 * fq);
}
__device__ __forceinline__ void rs8_finish(float (&rs)[2][4], const f32x4 (&v)[2][4]) {
#pragma unroll
    for (int ai = 0; ai < 2; ++ai)
#pragma unroll
        for (int m = 0; m < 4; ++m) { float s = (v[ai][m][0] + v[ai][m][1]) + (v[ai][m][2] + v[ai][m][3]); s += __shfl_xor(s, 16); s += __shfl_xor(s, 32); rs[ai][m] = __builtin_amdgcn_rsqf(s * (1.0f / 1024.0f) + 1e-6f); }
}
template <class Epi, class Sched, bool ALIGN_EPI = false, bool SP2 = false>
__device__ __forceinline__ void gemm_phase(PG8_LAS unsigned char* lds, const Gemm g, const Sched& S, const Epi& E) {
    int tid_ = threadIdx.x; asm volatile("" : "+v"(tid_));
    const int tid = tid_, wid = __builtin_amdgcn_readfirstlane(tid >> 6), lane = tid & 63, wr = wid >> 2, wc = wid & 3, fr = lane & 15, fq = lane >> 4;
    const int K = g.K, nt = K / BK;
    unsigned voffA[2], voffB[2];
#pragma unroll
    for (int i = 0; i < 2; ++i) { int R, C; stage_rc(tid * 16 + i * 8192, R, C); const int Rb = Epi::PERM ? ((R & ~31) + perm32(R & 31)) : R;
        voffA[i] = (unsigned)(R * K + C) * 2u; voffB[i] = (unsigned)(Rb * K + C) * 2u; }
    const size_t kstep = (size_t)(BK * 2);
    const size_t hstep = (size_t)HALF * K * 2;
    const size_t tstep = 2 * hstep;
    const unsigned ldsw = (unsigned)wid * 1024u;
    const int aoff = lds_byte(wr * 64 + fr, fq * 8), boff = lds_byte(wc * 32 + fr, fq * 8);
#define PG8_SA(b, h) (((b) * 2 + (h)) * HTB)
#define PG8_SB(b, h) ((4 + (b) * 2 + (h)) * HTB)
#define PG8_STAGE(bufoff, gbase, voff) do { _Pragma("unroll") for (int _i = 0; _i < 2; ++_i) \
        __builtin_amdgcn_global_load_lds((const unsigned*)((const char*)(gbase) + (voff)[_i]), (PG8_LAS unsigned*)(lds + (bufoff) + ldsw + _i * 8192), 16, 0, 0); } while (0)
#define PG8_LDA(dst, b, h) do { _Pragma("unroll") for (int m = 0; m < 4; ++m) _Pragma("unroll") for (int k = 0; k < 2; ++k) dst[m][k] = *(const PG8_LAS bf16x8*)(lds + PG8_SA(b, h) + aoff + m * 2048 + k * 1024); } while (0)
#define PG8_LDB(dst, b, h) do { _Pragma("unroll") for (int n = 0; n < 2; ++n) _Pragma("unroll") for (int k = 0; k < 2; ++k) dst[n][k] = *(const PG8_LAS bf16x8*)(lds + PG8_SB(b, h) + boff + n * 2048 + k * 1024); } while (0)
#define PG8_MMA(ai, bj, At, Bt) do { __builtin_amdgcn_s_setprio(1); _Pragma("unroll") for (int m = 0; m < 4; ++m) _Pragma("unroll") for (int n = 0; n < 2; ++n) _Pragma("unroll") for (int k = 0; k < 2; ++k) \
        acc[ai][bj][m][n] = __builtin_amdgcn_mfma_f32_16x16x32_bf16(Bt[n][k], At[m][k], acc[ai][bj][m][n], 0, 0, 0); __builtin_amdgcn_s_setprio(0); } while (0)
#define PG8_WAIT_V(n) asm volatile("s_waitcnt vmcnt(" #n ")" ::: "memory")
#define PG8_WAIT_L(n) asm volatile("s_waitcnt lgkmcnt(" #n ")" ::: "memory")
#define PG8_BAR __builtin_amdgcn_s_barrier()
#define PG8_SCHED __builtin_amdgcn_sched_barrier(0)
    Unit cur, nxt; int ui = 0;
    if (!S.next(0, cur)) return;
    f32x4 acc[2][2][4][2];
    float rs8[2][4];
#pragma unroll
    for (int a_ = 0; a_ < 2; ++a_)
#pragma unroll
        for (int m_ = 0; m_ < 4; ++m_) rs8[a_][m_] = 1.0f;
    bf16x8 At[4][2], B0[2][2], B1[2][2];
    const char* cA = (const char*)g.A + (size_t)cur.pm * tstep; const char* cB = (const char*)g.Bt + (size_t)cur.pn * tstep;
    S.a_ready(cur);
    if constexpr (SP2) {
        PG8_STAGE(PG8_SB(0, 0), cB, voffB); PG8_STAGE(PG8_SB(0, 1), cB + hstep, voffB); PG8_STAGE(PG8_SA(0, 0), cA, voffA); PG8_STAGE(PG8_SA(0, 1), cA + hstep, voffA);
        E.init(acc, cur, wr, wc, fr, fq);
        { f32x4 raw_[2][4]; if (E.rs_src()) { rs8_issue(raw_, E.rs_src(), cur.pm * BM + wr * 64 + fr, fq); rs8_finish(rs8, raw_); } }
        if (wr == 1) PG8_BAR;
        PG8_WAIT_V(2); PG8_BAR;
        PG8_STAGE(PG8_SB(1, 0), cB + kstep, voffB); PG8_STAGE(PG8_SA(1, 0), cA + kstep, voffA); PG8_STAGE(PG8_SB(1, 1), cB + hstep + kstep, voffB);
        PG8_WAIT_V(6); PG8_BAR;
    } else {
        PG8_STAGE(PG8_SB(0, 0), cB, voffB); PG8_STAGE(PG8_SA(0, 0), cA, voffA); PG8_STAGE(PG8_SB(0, 1), cB + hstep, voffB); PG8_STAGE(PG8_SA(0, 1), cA + hstep, voffA);
        E.init(acc, cur, wr, wc, fr, fq);
        { f32x4 raw_[2][4]; if (E.rs_src()) { rs8_issue(raw_, E.rs_src(), cur.pm * BM + wr * 64 + fr, fq); rs8_finish(rs8, raw_); } }
        if (wr == 1) PG8_BAR;
        PG8_WAIT_V(4); PG8_BAR;
        PG8_STAGE(PG8_SB(1, 0), cB + kstep, voffB); PG8_STAGE(PG8_SA(1, 0), cA + kstep, voffA); PG8_STAGE(PG8_SB(1, 1), cB + hstep + kstep, voffB);
        PG8_WAIT_V(6); PG8_BAR;
    }
    for (;;) {
        const bool has_next = S.next(ui + 1, nxt);
        const char* nA = has_next ? (const char*)g.A + (size_t)nxt.pm * tstep : cA; const char* nB = has_next ? (const char*)g.Bt + (size_t)nxt.pn * tstep : cB;
        for (int t = 0; t < nt; t += 2) {
            const bool last = (t == nt - 2);
            const char* a1 = cA + (size_t)(t + 1) * kstep;
            const char* a2 = last ? nA : cA + (size_t)(t + 2) * kstep; const char* b2 = last ? nB : cB + (size_t)(t + 2) * kstep;
            const char* a3 = a2 + kstep; const char* b3 = b2 + kstep;
            if (last && has_next) S.a_ready(nxt);
            if constexpr (SP2) {
            PG8_LDB(B0, 0, 0); PG8_LDB(B1, 0, 1); PG8_SCHED; PG8_LDA(At, 0, 0); PG8_STAGE(PG8_SA(1, 1), a1 + hstep, voffA);
            PG8_WAIT_V(8); PG8_WAIT_L(0); PG8_BAR; PG8_MMA(0, 0, At, B0); PG8_MMA(0, 1, At, B1); PG8_BAR; PG8_SCHED;
            PG8_LDA(At, 0, 1); PG8_STAGE(PG8_SB(0, 0), b2, voffB); PG8_STAGE(PG8_SB(0, 1), b2 + hstep, voffB); PG8_STAGE(PG8_SA(0, 0), a2, voffA);
            PG8_WAIT_V(8); PG8_WAIT_L(0); PG8_BAR; PG8_MMA(1, 0, At, B0); PG8_MMA(1, 1, At, B1); PG8_BAR; PG8_SCHED;
            PG8_LDB(B0, 1, 0); PG8_LDB(B1, 1, 1); PG8_SCHED; PG8_LDA(At, 1, 0); PG8_STAGE(PG8_SA(0, 1), a2 + hstep, voffA);
            PG8_WAIT_V(8); PG8_WAIT_L(0); PG8_BAR; PG8_MMA(0, 0, At, B0); PG8_MMA(0, 1, At, B1); PG8_BAR; PG8_SCHED;
            PG8_LDA(At, 1, 1); PG8_STAGE(PG8_SB(1, 0), b3, voffB); PG8_STAGE(PG8_SB(1, 1), b3 + hstep, voffB); PG8_STAGE(PG8_SA(1, 0), a3, voffA);
            PG8_WAIT_V(8); PG8_WAIT_L(0); PG8_BAR; PG8_MMA(1, 0, At, B0); PG8_MMA(1, 1, At, B1); PG8_BAR; PG8_SCHED;
            } else {
            PG8_LDB(B0, 0, 0); PG8_SCHED; PG8_LDA(At, 0, 0); PG8_STAGE(PG8_SA(1, 1), a1 + hstep, voffA);
            PG8_WAIT_L(8); PG8_BAR; PG8_WAIT_L(0); PG8_MMA(0, 0, At, B0); PG8_BAR; PG8_SCHED;
            PG8_LDB(B1, 0, 1); PG8_STAGE(PG8_SB(0, 0), b2, voffB);
            PG8_BAR; PG8_WAIT_L(0); PG8_MMA(0, 1, At, B1); PG8_BAR;
            PG8_LDA(At, 0, 1); PG8_STAGE(PG8_SA(0, 0), a2, voffA);
            PG8_BAR; PG8_WAIT_L(0); PG8_MMA(1, 0, At, B0); PG8_BAR; PG8_SCHED;
            PG8_STAGE(PG8_SB(0, 1), b2 + hstep, voffB);
            PG8_WAIT_V(6); PG8_BAR; PG8_MMA(1, 1, At, B1); PG8_BAR;
            PG8_LDB(B0, 1, 0); PG8_SCHED; PG8_LDA(At, 1, 0); PG8_STAGE(PG8_SA(0, 1), a2 + hstep, voffA);
            PG8_WAIT_L(8); PG8_BAR; PG8_WAIT_L(0); PG8_MMA(0, 0, At, B0); PG8_BAR; PG8_SCHED;
            PG8_LDB(B1, 1, 1); PG8_STAGE(PG8_SB(1, 0), b3, voffB);
            PG8_BAR; PG8_WAIT_L(0); PG8_MMA(0, 1, At, B1); PG8_BAR;
            PG8_LDA(At, 1, 1); PG8_STAGE(PG8_SA(1, 0), a3, voffA);
            PG8_BAR; PG8_WAIT_L(0); PG8_MMA(1, 0, At, B0); PG8_BAR; PG8_SCHED;
            PG8_STAGE(PG8_SB(1, 1), b3 + hstep, voffB);
            PG8_WAIT_V(6); PG8_BAR; PG8_MMA(1, 1, At, B1); PG8_BAR;
            }
        }
        if constexpr (ALIGN_EPI) { if (wr == 0) PG8_BAR; }
        if constexpr (!Epi::AFTER_DRAIN) { E(acc, rs8, cur, wr, wc, fr, fq, !has_next); S.done(cur); }
        if (has_next && E.rs_src()) { f32x4 rawn[2][4]; rs8_issue(rawn, E.rs_src(), nxt.pm * BM + wr * 64 + fr, fq); rs8_finish(rs8, rawn); }
        if (!has_next) break;
        E.init(acc, nxt, wr, wc, fr, fq);
        cur = nxt; cA = nA; cB = nB; ++ui;
        if constexpr (ALIGN_EPI) { if (wr == 1) PG8_BAR; }
    }
    PG8_WAIT_V(0);
    if constexpr (!ALIGN_EPI) { if (wr == 0) PG8_BAR; }
    PG8_BAR;
    if constexpr (Epi::AFTER_DRAIN) { E.fused(acc, cur, wr, wc, fr, fq, lds, wid, lane); S.done(cur); }
#undef PG8_SA
#undef PG8_SB
#undef PG8_STAGE
#undef PG8_LDA
#undef PG8_LDB
#undef PG8_MMA
#undef PG8_WAIT_V
#undef PG8_WAIT_L
#undef PG8_BAR
#undef PG8_SCHED
}
}

namespace pg8 {
constexpr float kEps = 1e-6f;
constexpr float kLog2e = 1.4426950408889634f;
constexpr float kC2 = 0.125f * 1.4426950408889634f;
__device__ __forceinline__ float rsq_f(float v) { return __builtin_amdgcn_rsqf(v); }
__device__ __forceinline__ float row_rs(const float* ssq, int row, int fq) {
    const f32x4 v = *(const f32x4*)(ssq + (size_t)row * 16 + 4 * fq);
    float s = (v[0] + v[1]) + (v[2] + v[3]);
    s += __shfl_xor(s, 16); s += __shfl_xor(s, 32);
    return rsq_f(s * (1.0f / 1024.0f) + kEps);
}
__device__ __forceinline__ void acc_zero(f32x4 (&acc)[2][2][4][2]) {
#pragma unroll
    for (int a = 0; a < 2; ++a)
#pragma unroll
        for (int b = 0; b < 2; ++b)
#pragma unroll
            for (int m = 0; m < 4; ++m)
#pragma unroll
                for (int n = 0; n < 2; ++n) acc[a][b][m][n] = (f32x4){0.f, 0.f, 0.f, 0.f};
}
__device__ __forceinline__ void row_rs8(float (&rs)[2][4], const float* ssq, int row0, int fq) {
    f32x4 v[2][4];
#pragma unroll
    for (int ai = 0; ai < 2; ++ai)
#pragma unroll
        for (int m = 0; m < 4; ++m) v[ai][m] = *(const f32x4*)(ssq + (size_t)(row0 + ai * HALF + m * 16) * 16 + 4 * fq);
#pragma unroll
    for (int ai = 0; ai < 2; ++ai)
#pragma unroll
        for (int m = 0; m < 4; ++m) { float s = (v[ai][m][0] + v[ai][m][1]) + (v[ai][m][2] + v[ai][m][3]); s += __shfl_xor(s, 16); s += __shfl_xor(s, 32); rs[ai][m] = rsq_f(s * (1.0f / 1024.0f) + kEps); }
}
__device__ __forceinline__ void st16(void* p, u32x4 v) { asm volatile("global_store_dwordx4 %0, %1, off\n\ts_nop 1" : : "v"(p), "v"(v) : "memory"); }
__device__ __forceinline__ void st16_wt(void* p, u32x4 v) { asm volatile("global_store_dwordx4 %0, %1, off sc1\n\ts_nop 1" : : "v"(p), "v"(v) : "memory"); }
__device__ __forceinline__ void st8_wt(void* p, u32x2 v) { asm volatile("global_store_dwordx2 %0, %1, off sc1\n\ts_nop 1" : : "v"(p), "v"(v) : "memory"); }
__device__ __forceinline__ void st16f(void* p, f32x4 v) { asm volatile("global_store_dwordx4 %0, %1, off\n\ts_nop 1" : : "v"(p), "v"(v) : "memory"); }
__device__ __forceinline__ float sigmoid_f(float y) { return __builtin_amdgcn_rcpf(1.0f + __builtin_amdgcn_exp2f(-kLog2e * y)); }
__device__ __forceinline__ float gelu_tanh_f(float x) {
    const float t = x * (1.0f + 0.044715f * x * x);
    return x * __builtin_amdgcn_rcpf(1.0f + __builtin_amdgcn_exp2f(-2.302208198f * t));
}
__device__ __forceinline__ float bf_lo(unsigned w) { return __uint_as_float(w << 16); }
__device__ __forceinline__ float bf_hi(unsigned w) { return __uint_as_float(w & 0xffff0000u); }

struct EpiAct {
    static constexpr bool PERM = true, AFTER_DRAIN = false;
    bf16_t* O; int ldc; const float* ssq_in; float* ssq_out; int act;
    __device__ __forceinline__ void init(f32x4 (&acc)[2][2][4][2], const Unit&, int, int, int, int) const { acc_zero(acc); }
    __device__ __forceinline__ const float* rs_src() const { return ssq_in; }
    __device__ __forceinline__ void operator()(const f32x4 (&acc)[2][2][4][2], const float (&rsa)[2][4], const Unit& u, int wr, int wc, int fr, int fq, bool wt) const {
        const int row0 = u.pm * BM + wr * 64 + fr, col0 = u.pn * BM + wc * 32 + 8 * fq;
        const bool want = (act == 1) && (u.pn >= 4);
#pragma unroll
        for (int ai = 0; ai < 2; ++ai)
#pragma unroll
            for (int m = 0; m < 4; ++m) {
                const int row = row0 + ai * HALF + m * 16;
                const float rs = ssq_in ? rsa[ai][m] : 1.0f;
                float q = 0.f;
#pragma unroll
                for (int bj = 0; bj < 2; ++bj) {
                    f32x4 v0 = acc[ai][bj][m][0] * rs, v1 = acc[ai][bj][m][1] * rs;
                    if (act == 1) {
#pragma unroll
                        for (int j = 0; j < 4; ++j) { v0[j] = gelu_tanh_f(v0[j]); v1[j] = gelu_tanh_f(v1[j]); }
                    } else if (act == 2) {
#pragma unroll
                        for (int j = 0; j < 4; ++j) { const float a = fmaxf(v0[j], 0.f), b = fmaxf(v1[j], 0.f); v0[j] = a * a; v1[j] = b * b; }
                    }
                    if (want) q += (v0[0] * v0[0] + v0[1] * v0[1]) + (v0[2] * v0[2] + v0[3] * v0[3]) + (v1[0] * v1[0] + v1[1] * v1[1]) + (v1[2] * v1[2] + v1[3] * v1[3]);
                    u32x4 w; w.x = cvt_pk_bf16(v0[0], v0[1]); w.y = cvt_pk_bf16(v0[2], v0[3]); w.z = cvt_pk_bf16(v1[0], v1[1]); w.w = cvt_pk_bf16(v1[2], v1[3]);
                    if (wt) st16_wt(O + (size_t)row * ldc + col0 + bj * HALF, w); else *(u32x4*)(O + (size_t)row * ldc + col0 + bj * HALF) = w;
                }
                if (want) { q += __shfl_xor(q, 16); q += __shfl_xor(q, 32); if (fq == 0) ssq_out[(size_t)row * 16 + (u.pn - 4) * 4 + wc] = q; }
            }
    }
};

template <bool FINAL> struct EpiResT {
    static constexpr bool PERM = true, AFTER_DRAIN = false;
    const bf16_t* xr; bf16_t* xb; float* xout; float* ssq_out; const float* ssq_in; const bf16_t* pp; int gate;
    __device__ __forceinline__ void init(f32x4 (&acc)[2][2][4][2], const Unit& u, int wr, int wc, int fr, int fq) const {
        if (gate) { acc_zero(acc); return; }
        const int row0 = u.pm * BM + wr * 64 + fr, col0 = u.pn * BM + wc * 32 + 8 * fq;
        u32x4 w[2][4][2];
#pragma unroll
        for (int ai = 0; ai < 2; ++ai)
#pragma unroll
            for (int m = 0; m < 4; ++m)
#pragma unroll
                for (int bj = 0; bj < 2; ++bj) w[ai][m][bj] = *(const u32x4*)(xr + (size_t)(row0 + ai * HALF + m * 16) * 1024 + col0 + bj * HALF);
#pragma unroll
        for (int ai = 0; ai < 2; ++ai)
#pragma unroll
            for (int m = 0; m < 4; ++m)
#pragma unroll
                for (int bj = 0; bj < 2; ++bj) { const u32x4 t = w[ai][m][bj];
                    acc[ai][bj][m][0] = (f32x4){bf_lo(t.x), bf_hi(t.x), bf_lo(t.y), bf_hi(t.y)}; acc[ai][bj][m][1] = (f32x4){bf_lo(t.z), bf_hi(t.z), bf_lo(t.w), bf_hi(t.w)}; }
    }
    __device__ __forceinline__ const float* rs_src() const { return gate ? ssq_in : nullptr; }
    __device__ __forceinline__ void operator()(const f32x4 (&acc)[2][2][4][2], const float (&rsa)[2][4], const Unit& u, int wr, int wc, int fr, int fq, bool wt) const {
        const int row0 = u.pm * BM + wr * 64 + fr, col0 = u.pn * BM + wc * 32 + 8 * fq;
        u32x4 xa[2], pa[2];
        if (gate) {
#pragma unroll
            for (int bj = 0; bj < 2; ++bj) { const size_t off = (size_t)row0 * 1024 + col0 + bj * HALF; xa[bj] = *(const u32x4*)(xr + off); pa[bj] = *(const u32x4*)(pp + off); }
        }
#pragma unroll
        for (int ai = 0; ai < 2; ++ai)
#pragma unroll
            for (int m = 0; m < 4; ++m) {
                const int row = row0 + ai * HALF + m * 16;
                u32x4 xc[2], pc[2];
                if (gate) {
#pragma unroll
                    for (int bj = 0; bj < 2; ++bj) { xc[bj] = xa[bj]; pc[bj] = pa[bj]; }
                    if (ai * 4 + m < 7) { const int nrow = row0 + ((ai * 4 + m + 1) >> 2) * HALF + ((ai * 4 + m + 1) & 3) * 16;
#pragma unroll
                        for (int bj = 0; bj < 2; ++bj) { const size_t off = (size_t)nrow * 1024 + col0 + bj * HALF; xa[bj] = *(const u32x4*)(xr + off); pa[bj] = *(const u32x4*)(pp + off); } }
                }
                float q = 0.f;
#pragma unroll
                for (int bj = 0; bj < 2; ++bj) {
                    const size_t off = (size_t)row * 1024 + col0 + bj * HALF;
                    f32x4 v0 = acc[ai][bj][m][0], v1 = acc[ai][bj][m][1];
                    if (gate) {
                        const float rs = rsa[ai][m]; const u32x4 pw = pc[bj], xw = xc[bj];
                        v0[0] = bf_lo(xw.x) + bf_lo(pw.x) * sigmoid_f(rs * v0[0]); v0[1] = bf_hi(xw.x) + bf_hi(pw.x) * sigmoid_f(rs * v0[1]);
                        v0[2] = bf_lo(xw.y) + bf_lo(pw.y) * sigmoid_f(rs * v0[2]); v0[3] = bf_hi(xw.y) + bf_hi(pw.y) * sigmoid_f(rs * v0[3]);
                        v1[0] = bf_lo(xw.z) + bf_lo(pw.z) * sigmoid_f(rs * v1[0]); v1[1] = bf_hi(xw.z) + bf_hi(pw.z) * sigmoid_f(rs * v1[1]);
                        v1[2] = bf_lo(xw.w) + bf_lo(pw.w) * sigmoid_f(rs * v1[2]); v1[3] = bf_hi(xw.w) + bf_hi(pw.w) * sigmoid_f(rs * v1[3]);
                    }
                    if constexpr (FINAL) { *(f32x4*)(xout + off) = v0; *(f32x4*)(xout + off + 4) = v1; }
                    else {
                        q += (v0[0] * v0[0] + v0[1] * v0[1]) + (v0[2] * v0[2] + v0[3] * v0[3]) + (v1[0] * v1[0] + v1[1] * v1[1]) + (v1[2] * v1[2] + v1[3] * v1[3]);
                        u32x4 w; w.x = cvt_pk_bf16(v0[0], v0[1]); w.y = cvt_pk_bf16(v0[2], v0[3]); w.z = cvt_pk_bf16(v1[0], v1[1]); w.w = cvt_pk_bf16(v1[2], v1[3]);
                        if (wt) st16_wt(xb + off, w); else *(u32x4*)(xb + off) = w;
                    }
                }
                if constexpr (!FINAL) { q += __shfl_xor(q, 16); q += __shfl_xor(q, 32); if (fq == 0) ssq_out[(size_t)row * 16 + u.pn * 4 + wc] = q; }
            }
    }
};

struct EpiQKV {
    static constexpr bool PERM = true, AFTER_DRAIN = false;
    bf16_t* QKV; size_t tstride; const float* ssq_in; const float* gq; const float* gk;
    __device__ __forceinline__ void init(f32x4 (&acc)[2][2][4][2], const Unit&, int, int, int, int) const { acc_zero(acc); }
    __device__ __forceinline__ const float* rs_src() const { return ssq_in; }
    __device__ __forceinline__ void operator()(const f32x4 (&acc)[2][2][4][2], const float (&rsa)[2][4], const Unit& u, int wr, int wc, int fr, int fq, bool wt) const {
        const int row0 = u.pm * BM + wr * 64 + fr; const int t = u.pn >> 2;
        bf16_t* base = QKV + (size_t)t * tstride; const int colb = (u.pn & 3) * BM + 64 * wc + 8 * fq;
        const float* gp = (t == 0) ? gq : gk; const float sc = (t == 0) ? kC2 : 1.0f;
        f32x4 gg[2][2];
#pragma unroll
        for (int bj = 0; bj < 2; ++bj) { gg[bj][0] = (f32x4){1.f, 1.f, 1.f, 1.f}; gg[bj][1] = gg[bj][0]; if (t < 2) { gg[bj][0] = *(const f32x4*)(gp + 32 * bj + 8 * fq); gg[bj][1] = *(const f32x4*)(gp + 32 * bj + 8 * fq + 4); } }
#pragma unroll
        for (int ai = 0; ai < 2; ++ai)
#pragma unroll
            for (int m = 0; m < 4; ++m) {
                const int row = row0 + ai * HALF + m * 16;
                const float rs = rsa[ai][m];
                float q = 0.f;
#pragma unroll
                for (int bj = 0; bj < 2; ++bj)
#pragma unroll
                    for (int n = 0; n < 2; ++n) { const f32x4 a = acc[ai][bj][m][n]; q += (a[0] * a[0] + a[1] * a[1]) + (a[2] * a[2] + a[3] * a[3]); }
                q *= rs * rs;
                q += __shfl_xor(q, 16); q += __shfl_xor(q, 32);
                const float hn = ((t < 2) ? rsq_f(q * (1.0f / 64.0f) + kEps) * sc : 1.0f) * rs;
#pragma unroll
                for (int bj = 0; bj < 2; ++bj) {
                    const f32x4 v0 = acc[ai][bj][m][0] * hn * gg[bj][0], v1 = acc[ai][bj][m][1] * hn * gg[bj][1];
                    u32x4 w; w.x = cvt_pk_bf16(v0[0], v0[1]); w.y = cvt_pk_bf16(v0[2], v0[3]); w.z = cvt_pk_bf16(v1[0], v1[1]); w.w = cvt_pk_bf16(v1[2], v1[3]);
                    if (wt) st16_wt(base + (size_t)row * 1024 + colb + 32 * bj, w); else st16(base + (size_t)row * 1024 + colb + 32 * bj, w);
                }
            }
    }
};
}

#define LAS __attribute__((address_space(3)))
typedef unsigned short bf16;
typedef unsigned v4u __attribute__((ext_vector_type(4)));
typedef unsigned v2u __attribute__((ext_vector_type(2)));
typedef float f32x4 __attribute__((ext_vector_type(4)));
typedef float f32x16 __attribute__((ext_vector_type(16)));
typedef short bf16x8 __attribute__((ext_vector_type(8)));
typedef short s16x4 __attribute__((ext_vector_type(4)));
typedef _Float16 f16x8 __attribute__((ext_vector_type(8)));

#ifndef MK_SINGLE
#define MK_SINGLE 1
#endif

constexpr int NWAVES = 8;
constexpr int BATCH = 8, SEQ = 2048, D = 1024, H = 16, HD = 64, FF = 4096, PLE = 256, CHUNK = 128, NGRP = 8;
constexpr int M = BATCH * SEQ;
constexpr size_t MiB = 1u << 20;
constexpr size_t WS_CTL = 0;
constexpr size_t WS_SSQ = 1 * MiB;
constexpr size_t WS_WIN = 9 * MiB, WS_WOA = 13 * MiB, WS_WQKV = 15 * MiB, WS_WOB = 21 * MiB, WS_WUP = 23 * MiB, WS_WDN = 39 * MiB, WS_WG = 55 * MiB, WS_WPP = 59 * MiB;
constexpr size_t WS_PBF = 60 * MiB;
constexpr size_t WS_XB = 76 * MiB;
constexpr size_t WS_BIG = 108 * MiB;
constexpr size_t WS_END = 236 * MiB;
constexpr int LDS_BYTES = 147456;
enum { SQ_X0 = 0, SQ_V = 1, SQ_X1 = 2, SQ_X2 = 3, SQ_X3 = 4, SQ_X4 = 5, SQ_X5 = 6, SQ_X6 = 7 };

struct Args {
    const float* in[21];
    float* out; unsigned char* ws; int lo, hi;
};

struct Frame {
    LAS unsigned char* lds; int vcu, G;
};

__device__ __forceinline__ unsigned f2bf(float f) { unsigned u = __builtin_bit_cast(unsigned, f); return (u + 0x7fffu + ((u >> 16) & 1u)) >> 16; }
__device__ __forceinline__ unsigned pk2(float lo, float hi) { return f2bf(lo) | (f2bf(hi) << 16); }
__device__ __forceinline__ float wave_sum(float v) {
#pragma unroll
    for (int o = 1; o < 64; o <<= 1) v += __shfl_xor(v, o);
    return v;
}

__device__ __forceinline__ void tr_item(const float* W, int K, int N, const float* gain, bf16* WT, int row_off, bool headperm, LAS float* scr, int item, int lane) {
    const int nblk = N / 32, kb = item / nblk, nb = item % nblk, k0 = 64 * kb, n0 = 32 * nb;
    f32x4 w[8];
#pragma unroll
    for (int i = 0; i < 8; ++i) { const int idx = i * 64 + lane, kk = idx >> 3, n4 = idx & 7; w[i] = __builtin_nontemporal_load((const f32x4*)(W + (size_t)(k0 + kk) * N + n0 + 4 * n4)); }
    if (gain) {
#pragma unroll
        for (int i = 0; i < 8; ++i) { const int kk = (i * 64 + lane) >> 3; w[i] = w[i] * gain[k0 + kk]; }
    }
#pragma unroll
    for (int i = 0; i < 8; ++i) { const int idx = i * 64 + lane, kk = idx >> 3, n4 = idx & 7; LAS float* d = scr + kk * 33 + 4 * n4; d[0] = w[i][0]; d[1] = w[i][1]; d[2] = w[i][2]; d[3] = w[i][3]; }
    asm volatile("s_waitcnt lgkmcnt(0)" ::: "memory");
    int d0 = n0;
    if (headperm) { const int ja = n0 & 255, wc = ja >> 6, bj = (ja >> 5) & 1; d0 = (n0 - ja) + 128 * bj + 32 * wc; }
    const int c = lane & 7;
#pragma unroll
    for (int j = 0; j < 4; ++j) { const int n = (lane >> 3) + 8 * j; const LAS float* s = scr + (8 * c) * 33 + n;
        v4u o; o.x = pk2(s[0 * 33], s[1 * 33]); o.y = pk2(s[2 * 33], s[3 * 33]); o.z = pk2(s[4 * 33], s[5 * 33]); o.w = pk2(s[6 * 33], s[7 * 33]);
        *(v4u*)(WT + (size_t)(row_off + d0 + n) * K + k0 + 8 * c) = o; }
    asm volatile("s_waitcnt lgkmcnt(0)" ::: "memory");
}

__device__ __forceinline__ const float* pick_in(const Args& a, int i) {
    const float* p = a.in[2];
    switch (i) { case 3: p = a.in[3]; break; case 7: p = a.in[7]; break; case 8: p = a.in[8]; break; case 9: p = a.in[9]; break; case 11: p = a.in[11]; break; case 12: p = a.in[12]; break;
                 case 14: p = a.in[14]; break; case 15: p = a.in[15]; break; case 16: p = a.in[16]; break; case 17: p = a.in[17]; break; case 18: p = a.in[18]; break; case 19: p = a.in[19]; break; case 20: p = a.in[20]; break; default: break; }
    return p;
}
__device__ __forceinline__ void prologue_phase(const Frame& F, const Args& a) {
    unsigned char* ws = a.ws;
    int tid_ = threadIdx.x; asm volatile("" : "+v"(tid_));
    const int lane_ = tid_ & 63, wave_ = __builtin_amdgcn_readfirstlane(tid_ >> 6);
    LAS float* scr = (LAS float*)(F.lds + wave_ * 16384);
    const int gw = F.vcu * NWAVES + wave_, NGW = F.G * NWAVES;
    constexpr int I_IN = (D / 64) * (2 * D / 32), I_SQ = (D / 64) * (D / 32), I_KV = I_IN, I_UP = (D / 64) * (FF / 32), I_DN = (FF / 64) * (D / 32), I_PP = (PLE / 64) * (D / 32);
    constexpr int NITEMS = I_IN + I_SQ + I_SQ + I_KV + I_SQ + 2 * I_UP + 2 * I_DN + 2 * I_SQ + 2 * I_PP;
    for (int i = 4 * gw; i < (2 * M * PLE) / 512; i += 4 * NGW) {
        const f32x4* pr = (const f32x4*)(a.in[1] + (size_t)i * 512) + 2 * lane_;
        f32x4 x[8];
#pragma unroll
        for (int j = 0; j < 4; ++j) { x[2 * j] = __builtin_nontemporal_load(pr + 128 * j); x[2 * j + 1] = __builtin_nontemporal_load(pr + 128 * j + 1); }
#pragma unroll
        for (int j = 0; j < 4; ++j) { v4u o; o.x = pk2(x[2 * j].x, x[2 * j].y); o.y = pk2(x[2 * j].z, x[2 * j].w); o.z = pk2(x[2 * j + 1].x, x[2 * j + 1].y); o.w = pk2(x[2 * j + 1].z, x[2 * j + 1].w);
            *((v4u*)((bf16*)(ws + WS_PBF) + (size_t)(i + j) * 512) + lane_) = o; }
    }
    for (int it = gw; it < NITEMS; it += NGW) {
        int r = NITEMS - 1 - it, ii = 3, ig = 2, K = D, N = 2 * D, roff = 0; size_t woff = 0, dsto = WS_WIN; int goff = 0; bool hp = false, done = false;
        if (r < I_IN) { done = true; } else r -= I_IN;
        if (!done) { if (r < I_SQ) { ii = 7; ig = -1; N = D; dsto = WS_WOA; done = true; } else r -= I_SQ; }
        if (!done) { if (r < I_SQ) { ii = 12; ig = 11; N = D; dsto = WS_WQKV; hp = true; done = true; } else r -= I_SQ; }
        if (!done) { if (r < I_KV) { ii = 9; ig = 8; N = 2 * D; dsto = WS_WQKV; roff = D; hp = true; done = true; } else r -= I_KV; }
        if (!done) { if (r < I_SQ) { ii = 14; ig = -1; N = D; dsto = WS_WOB; done = true; } else r -= I_SQ; }
        if (!done) { if (r < 2 * I_UP) { const int l = r / I_UP; r -= l * I_UP; ii = 16; ig = 15; N = FF; woff = (size_t)l * D * FF; goff = l * D; dsto = WS_WUP + woff * 2; done = true; } else r -= 2 * I_UP; }
        if (!done) { if (r < 2 * I_DN) { const int l = r / I_DN; r -= l * I_DN; ii = 17; ig = -1; K = FF; N = D; woff = (size_t)l * D * FF; dsto = WS_WDN + woff * 2; done = true; } else r -= 2 * I_DN; }
        if (!done) { if (r < 2 * I_SQ) { const int l = r / I_SQ; r -= l * I_SQ; ii = 19; ig = 18; N = D; woff = (size_t)l * D * D; goff = l * D; dsto = WS_WG + woff * 2; done = true; } else r -= 2 * I_SQ; }
        if (!done) { const int l = r / I_PP; r -= l * I_PP; ii = 20; ig = -1; K = PLE; N = D; woff = (size_t)l * PLE * D; dsto = WS_WPP + woff * 2; }
        const float* Wp = pick_in(a, ii) + woff; const float* gp = (ig >= 0) ? pick_in(a, ig) + goff : nullptr;
        tr_item(Wp, K, N, gp, (bf16*)(ws + dsto), roff, hp, scr, r, lane_);
    }
    float* ssq0 = (float*)(ws + WS_SSQ) + (size_t)SQ_X0 * M * 16;
    for (int m = 2 * gw; m < M; m += 2 * NGW) {
        const f32x4* xr = (const f32x4*)(a.in[0] + (size_t)m * D) + lane_;
        f32x4 v[8]; float s0 = 0.f, s1 = 0.f;
#pragma unroll
        for (int j = 0; j < 8; ++j) v[j] = __builtin_nontemporal_load(xr + 64 * j);
#pragma unroll
        for (int j = 0; j < 4; ++j) { s0 += (v[j].x * v[j].x + v[j].y * v[j].y) + (v[j].z * v[j].z + v[j].w * v[j].w); s1 += (v[4 + j].x * v[4 + j].x + v[4 + j].y * v[4 + j].y) + (v[4 + j].z * v[4 + j].z + v[4 + j].w * v[4 + j].w); }
        s0 = wave_sum(s0); s1 = wave_sum(s1);
        unsigned long long* o8 = (unsigned long long*)((bf16*)(ws + WS_XB) + (size_t)m * D) + lane_;
#pragma unroll
        for (int j = 0; j < 8; ++j) o8[64 * j] = (unsigned long long)pk2(v[j].x, v[j].y) | ((unsigned long long)pk2(v[j].z, v[j].w) << 32);
        if (lane_ < 32) ssq0[(size_t)m * 16 + lane_] = (lane_ == 0) ? s0 : (lane_ == 16) ? s1 : 0.f;
    }
}

__device__ __forceinline__ void sgu_phase(const Frame& F, const Args& a) {
    unsigned char* ws = a.ws;
    const bf16* Z = (const bf16*)(ws + WS_BIG); bf16* Y = (bf16*)(ws + WS_BIG + 64 * MiB);
    const float* ssqv = (const float*)(ws + WS_SSQ) + (size_t)SQ_V * M * 16;
    const float* wsp = a.in[5]; const float* bsp = a.in[6]; const float* gv = a.in[4];
    constexpr int RS = 272;
    LAS unsigned char* WSL = F.lds; LAS unsigned char* VTL = F.lds + 128 * RS; LAS float* rsl = (LAS float*)(F.lds + 2 * 128 * RS);
    int tid_ = threadIdx.x; asm volatile("" : "+v"(tid_));
    const int tid = tid_, lane = tid & 63, w = __builtin_amdgcn_readfirstlane(tid >> 6), fr = lane & 15, fq = lane >> 4;
    for (int unit = F.vcu; unit < (M / CHUNK) * NGRP; unit += F.G) {
        const int c = unit >> 3, g = unit & 7, rowb = c * CHUNK;
        if (tid < 128) { const f32x4* sp = (const f32x4*)(ssqv + (size_t)(rowb + tid) * 16); const f32x4 s0 = sp[0], s1 = sp[1], s2 = sp[2], s3 = sp[3];
            const float s = ((s0[0] + s0[1]) + (s0[2] + s0[3])) + ((s1[0] + s1[1]) + (s1[2] + s1[3])) + ((s2[0] + s2[1]) + (s2[2] + s2[3])) + ((s3[0] + s3[1]) + (s3[2] + s3[3]));
            rsl[tid] = __builtin_amdgcn_rsqf(s * (1.0f / 1024.0f) + 1e-6f); }
        __syncthreads();
#pragma unroll
        for (int i = 0; i < 8; ++i) { const int idx = i * 512 + tid, t = idx >> 5, s4 = idx & 31;
            const f32x4 wv = *(const f32x4*)(wsp + (size_t)g * 16384 + t * 128 + 4 * s4); const f32x4 r = *(const LAS f32x4*)(rsl + 4 * s4);
            float e[4];
#pragma unroll
            for (int k = 0; k < 4; ++k) e[k] = (4 * s4 + k <= t) ? wv[k] * r[k] : 0.f;
            v2u o; o.x = pk2(e[0], e[1]); o.y = pk2(e[2], e[3]);
            *(LAS v2u*)(WSL + t * RS + s4 * 8) = o; }
#pragma unroll
        for (int i = 0; i < 4; ++i) { const int idx = i * 512 + tid, dc = idx >> 7, s = idx & 127;
            const v4u pv = *(const v4u*)(Z + (size_t)(rowb + s) * 2048 + 1024 + g * 128 + dc * 8);
#pragma unroll
            for (int j = 0; j < 8; ++j) { const unsigned hw = (pv[j >> 1] >> (16 * (j & 1))) & 0xffffu; *(LAS unsigned short*)(VTL + (dc * 8 + j) * RS + s * 2) = (unsigned short)hw; } }
        __syncthreads();
        const int t0 = 16 * w, nks = (w >> 1) + 1;
        bf16x8 wf[4];
#pragma unroll
        for (int ks = 0; ks < 4; ++ks) wf[ks] = (ks < nks) ? *(const LAS bf16x8*)(WSL + (t0 + fr) * RS + (32 * ks + 8 * fq) * 2) : (bf16x8){0, 0, 0, 0, 0, 0, 0, 0};
        f32x4 acc[8];
#pragma unroll
        for (int n = 0; n < 8; ++n) { acc[n] = (f32x4){0.f, 0.f, 0.f, 0.f};
#pragma unroll
            for (int ks = 0; ks < 4; ++ks) if (ks < nks) { const bf16x8 vf = *(const LAS bf16x8*)(VTL + (16 * n + fr) * RS + (32 * ks + 8 * fq) * 2);
                acc[n] = __builtin_amdgcn_mfma_f32_16x16x32_bf16(vf, wf[ks], acc[n], 0, 0, 0); } }
        const int t = t0 + fr, row = rowb + t; const float bias = bsp[g * 128 + t];
#pragma unroll
        for (int n = 0; n < 8; ++n) { const int col = g * 128 + 16 * n + 4 * fq;
            const f32x4 gg = *(const f32x4*)(gv + col); const v2u uu = *(const v2u*)(Z + (size_t)row * 2048 + col);
            const float y0 = __uint_as_float(uu.x << 16) * (gg[0] * acc[n][0] + bias), y1 = __uint_as_float(uu.x & 0xffff0000u) * (gg[1] * acc[n][1] + bias);
            const float y2 = __uint_as_float(uu.y << 16) * (gg[2] * acc[n][2] + bias), y3 = __uint_as_float(uu.y & 0xffff0000u) * (gg[3] * acc[n][3] + bias);
            v2u o; o.x = pk2(y0, y1); o.y = pk2(y2, y3);
            if (unit + F.G >= (M / CHUNK) * NGRP) pg8::st8_wt(Y + (size_t)row * 1024 + col, o); else *(v2u*)(Y + (size_t)row * 1024 + col) = o; }
        __syncthreads();
    }
}

__device__ __forceinline__ int crow(int r, int hi) { return (r & 3) + 8 * (r >> 2) + 4 * hi; }
__device__ __forceinline__ unsigned cvtpk_s(float lo, float hi) { typedef float f2 __attribute__((ext_vector_type(2))); typedef __bf16 b2 __attribute__((ext_vector_type(2))); f2 v = {lo, hi}; b2 b = __builtin_convertvector(v, b2); return __builtin_bit_cast(unsigned, b); }
__device__ __forceinline__ unsigned cvtpk_h(float lo, float hi) { typedef float f2 __attribute__((ext_vector_type(2))); typedef _Float16 h2 __attribute__((ext_vector_type(2))); f2 v = {lo, hi}; h2 h = __builtin_convertvector(v, h2); return __builtin_bit_cast(unsigned, h); }
constexpr int AT_K = 0, AT_V = 40960, AT_OST = 90112, AT_SLOT = 8192, AT_FLAG = 122880;
constexpr float ATT_CUT = 44.0f;
struct PFrag { bf16x8 a0, a1, a2, a3; };
__device__ __forceinline__ PFrag attn_front(const LAS unsigned char* kb, const bf16x8 (&qr)[4], f32x16& cvn, const f16x8 Ts0, const f16x8 Ts1, const f16x8 ONES, const bool needmask, const int kmin, const int tq, const int hi) {
    f32x16 p0 = f32x16{}, p1 = f32x16{};
#pragma unroll
    for (int d0 = 0; d0 < 4; ++d0) { const bf16x8 b0 = *(const LAS bf16x8*)(kb + d0 * 2048), b1 = *(const LAS bf16x8*)(kb + d0 * 2048 + 512);
        p0 = __builtin_amdgcn_mfma_f32_32x32x16_bf16(b0, qr[d0], p0, 0, 0, 0); p1 = __builtin_amdgcn_mfma_f32_32x32x16_bf16(b1, qr[d0], p1, 0, 0, 0); }
    f32x16 g0, g1;
#pragma unroll
    for (int r = 0; r < 16; ++r) { g0[r] = __builtin_amdgcn_logf(1.0f + __builtin_amdgcn_exp2f(p0[r])); g1[r] = __builtin_amdgcn_logf(1.0f + __builtin_amdgcn_exp2f(p1[r])); }
    if (needmask) {
#pragma unroll
        for (int r = 0; r < 16; ++r) { const int kv = kmin + crow(r, hi); if (kv >= tq) { g0[r] = 0.f; p0[r] = -INFINITY; } if (kv + 32 >= tq) { g1[r] = 0.f; p1[r] = -INFINITY; } }
    }
    unsigned n0[8], n1[8];
#pragma unroll
    for (int i = 0; i < 8; ++i) { n0[i] = cvtpk_h(-g0[2 * i], -g0[2 * i + 1]); n1[i] = cvtpk_h(-g1[2 * i], -g1[2 * i + 1]); }
    const f16x8 nl00 = __builtin_bit_cast(f16x8, (v4u){n0[0], n0[1], n0[2], n0[3]}), nl01 = __builtin_bit_cast(f16x8, (v4u){n0[4], n0[5], n0[6], n0[7]});
    const f16x8 nl10 = __builtin_bit_cast(f16x8, (v4u){n1[0], n1[1], n1[2], n1[3]}), nl11 = __builtin_bit_cast(f16x8, (v4u){n1[4], n1[5], n1[6], n1[7]});
    f32x16 U = __builtin_amdgcn_mfma_f32_32x32x16_f16(ONES, nl10, cvn, 0, 0, 0); U = __builtin_amdgcn_mfma_f32_32x32x16_f16(ONES, nl11, U, 0, 0, 0);
    f32x16 X1 = p1 + cvn;
    X1 = __builtin_amdgcn_mfma_f32_32x32x16_f16(Ts0, nl10, X1, 0, 0, 0); X1 = __builtin_amdgcn_mfma_f32_32x32x16_f16(Ts1, nl11, X1, 0, 0, 0);
    f32x16 X0 = p0 + U;
    X0 = __builtin_amdgcn_mfma_f32_32x32x16_f16(Ts0, nl00, X0, 0, 0, 0); X0 = __builtin_amdgcn_mfma_f32_32x32x16_f16(Ts1, nl01, X0, 0, 0, 0);
    cvn = __builtin_amdgcn_mfma_f32_32x32x16_f16(ONES, nl00, U, 0, 0, 0); cvn = __builtin_amdgcn_mfma_f32_32x32x16_f16(ONES, nl01, cvn, 0, 0, 0);
    unsigned pw[16];
#pragma unroll
    for (int i = 0; i < 8; ++i) { pw[i] = cvtpk_s(__builtin_amdgcn_exp2f(X0[2 * i]), __builtin_amdgcn_exp2f(X0[2 * i + 1])); pw[8 + i] = cvtpk_s(__builtin_amdgcn_exp2f(X1[2 * i]), __builtin_amdgcn_exp2f(X1[2 * i + 1])); }
    PFrag P;
    P.a0 = __builtin_bit_cast(bf16x8, (v4u){pw[0], pw[1], pw[2], pw[3]}); P.a1 = __builtin_bit_cast(bf16x8, (v4u){pw[4], pw[5], pw[6], pw[7]});
    P.a2 = __builtin_bit_cast(bf16x8, (v4u){pw[8], pw[9], pw[10], pw[11]}); P.a3 = __builtin_bit_cast(bf16x8, (v4u){pw[12], pw[13], pw[14], pw[15]});
    return P;
}
__device__ __forceinline__ void attn_pv(f32x16 (&o)[2], const int vb, const PFrag& P) {
#pragma unroll
    for (int d0 = 0; d0 < 2; ++d0) { s16x4 lo4[4], hi4[4];
#pragma unroll
        for (int ks = 0; ks < 4; ++ks) {
            asm volatile("ds_read_b64_tr_b16 %0,%1 offset:%c2" : "=&v"(lo4[ks]) : "v"(vb), "i"(d0 * 4096 + ks * 1024) : "memory");
            asm volatile("ds_read_b64_tr_b16 %0,%1 offset:%c2" : "=&v"(hi4[ks]) : "v"(vb), "i"(d0 * 4096 + ks * 1024 + 512) : "memory"); }
        asm volatile("s_waitcnt lgkmcnt(0)" ::: "memory"); __builtin_amdgcn_sched_barrier(0);
#define PKV(k) (bf16x8){lo4[k][0], lo4[k][1], lo4[k][2], lo4[k][3], hi4[k][0], hi4[k][1], hi4[k][2], hi4[k][3]}
        o[d0] = __builtin_amdgcn_mfma_f32_32x32x16_bf16(P.a0, PKV(0), o[d0], 0, 0, 0);
        o[d0] = __builtin_amdgcn_mfma_f32_32x32x16_bf16(P.a1, PKV(1), o[d0], 0, 0, 0);
        o[d0] = __builtin_amdgcn_mfma_f32_32x32x16_bf16(P.a2, PKV(2), o[d0], 0, 0, 0);
        o[d0] = __builtin_amdgcn_mfma_f32_32x32x16_bf16(P.a3, PKV(3), o[d0], 0, 0, 0);
#undef PKV
    }
}

__device__ __forceinline__ void attn_unit(int b, int h, int qb, const bf16* Q, const bf16* K, const bf16* V, bf16* O, LAS unsigned char* lds, bool wt) {
    int tid_ = threadIdx.x; asm volatile("" : "+v"(tid_));
    const int tid = tid_, lane = tid & 63, r32 = lane & 31, hi = lane >> 5; const int wid = __builtin_amdgcn_readfirstlane(tid >> 6);
    const long rowbase = (long)b * SEQ; const int q0 = qb * 256;
    const bf16* Qw = Q + (rowbase + q0 + wid * 32) * D + h * HD;
    const bf16* ksrc = K + (rowbase + lane) * D + h * HD + wid * 8;
    const bf16* vsrc = V + (rowbase + 16 * (wid & 3) + (lane >> 2)) * D + h * HD + (wid >> 2) * 32 + (lane & 3) * 8;
    const int sdst = wid * 1024 + lane * 16;
    const unsigned lds0 = (unsigned)(uintptr_t)lds;
    const int vb0 = (int)(lds0 + AT_V) + ((lane >> 4) & 1) * 32 + (lane & 3) * 8 + (4 * hi + ((lane & 15) >> 2)) * 64;
    const LAS unsigned char* kb0 = lds + AT_K + hi * 1024 + r32 * 16;
    bf16x8 qr[4];
#pragma unroll
    for (int d0 = 0; d0 < 4; ++d0) qr[d0] = *(const bf16x8*)(Qw + (long)r32 * D + d0 * 16 + hi * 8);
    const int NT = 4 * (qb + 1);
    f32x16 o[2]; o[0] = f32x16{}; o[1] = f32x16{};
    f32x16 cvn = f32x16{};
    f16x8 Ts0, Ts1, ONES;
#pragma unroll
    for (int jj = 0; jj < 8; ++jj) { const int k0 = 8 * (jj >> 2) + 4 * hi + (jj & 3); Ts0[jj] = (k0 >= r32) ? (_Float16)1.0f : (_Float16)0.0f; Ts1[jj] = (16 + k0 >= r32) ? (_Float16)1.0f : (_Float16)0.0f; ONES[jj] = (_Float16)1.0f; }
    const int tq = wid * 32 + r32;
#pragma unroll
    for (int j = 0; j < 4; ++j) { const int t = NT - 4 + j; const v4u kk = *(const v4u*)(ksrc + (long)t * 64 * D), vv = *(const v4u*)(vsrc + (long)t * 64 * D);
        *(LAS v4u*)(lds + AT_K + (t % 5) * AT_SLOT + sdst) = kk; *(LAS v4u*)(lds + AT_V + (t % 6) * AT_SLOT + sdst) = vv; }
    asm volatile("" : "+v"(qr[0]), "+v"(qr[1]), "+v"(qr[2]), "+v"(qr[3]));
    __syncthreads();
    LAS unsigned* flg = (LAS unsigned*)(lds + AT_FLAG);
    const int dw = NT - 4 + (wid >> 1);
    bool wdone = false;
    v4u kreg, vreg;
    if (wid < 4) {
        for (int it = 0; it < NT; ++it) {
            const int tn = NT - 5 - it, t = dw - it;
            if (tn >= 0) { kreg = *(const v4u*)(ksrc + (long)tn * 64 * D); vreg = *(const v4u*)(vsrc + (long)tn * 64 * D); }
            if (t < 0) wdone = true;
            if (!wdone) {
                const int kmin = 64 * (t - (NT - 4));
                const PFrag P = attn_front(kb0 + (t % 5) * AT_SLOT, qr, cvn, Ts0, Ts1, ONES, kmin + 63 >= wid * 32, kmin, tq, hi);
                attn_pv(o, vb0 + (t % 6) * AT_SLOT, P);
                wdone = __all(cvn[0] < -ATT_CUT);
            }
            if (tn >= 0) { *(LAS v4u*)(lds + AT_K + (tn % 5) * AT_SLOT + sdst) = kreg; *(LAS v4u*)(lds + AT_V + (tn % 6) * AT_SLOT + sdst) = vreg; }
            if (lane == 0) flg[(it & 1) * 8 + wid] = wdone ? 1u : 0u;
            __syncthreads();
            { const v4u f0 = *(const LAS v4u*)(flg + (it & 1) * 8), f1 = *(const LAS v4u*)(flg + (it & 1) * 8 + 4);
              if ((f0.x & f0.y & f0.z & f0.w & f1.x & f1.y & f1.z & f1.w) != 0u) break; }
        }
    } else {
        PFrag Pd; Pd.a0 = Pd.a1 = Pd.a2 = Pd.a3 = (bf16x8){0, 0, 0, 0, 0, 0, 0, 0}; bool have = false; int vprev = 0;
        for (int it = 0; it < NT; ++it) {
            const int tn = NT - 5 - it, t = dw - it;
            if (tn >= 0) { kreg = *(const v4u*)(ksrc + (long)tn * 64 * D); vreg = *(const v4u*)(vsrc + (long)tn * 64 * D); }
            if (have) { attn_pv(o, vb0 + vprev, Pd); have = false; }
            if (t < 0) wdone = true;
            if (!wdone) {
                const int kmin = 64 * (t - (NT - 4));
                Pd = attn_front(kb0 + (t % 5) * AT_SLOT, qr, cvn, Ts0, Ts1, ONES, kmin + 63 >= wid * 32, kmin, tq, hi); have = true; vprev = (t % 6) * AT_SLOT;
                wdone = __all(cvn[0] < -ATT_CUT);
            }
            if (tn >= 0) { *(LAS v4u*)(lds + AT_K + (tn % 5) * AT_SLOT + sdst) = kreg; *(LAS v4u*)(lds + AT_V + (tn % 6) * AT_SLOT + sdst) = vreg; }
            if (lane == 0) flg[(it & 1) * 8 + wid] = wdone ? 1u : 0u;
            __syncthreads();
            { const v4u f0 = *(const LAS v4u*)(flg + (it & 1) * 8), f1 = *(const LAS v4u*)(flg + (it & 1) * 8 + 4);
              if ((f0.x & f0.y & f0.z & f0.w & f1.x & f1.y & f1.z & f1.w) != 0u) break; }
        }
        if (have) attn_pv(o, vb0 + vprev, Pd);
    }
    bf16* Ow = O + (rowbase + q0 + wid * 32) * D + h * HD;
    LAS bf16* stg = (LAS bf16*)(lds + AT_OST + wid * 4096);
#pragma unroll
    for (int r = 0; r < 16; ++r) { const int orow = crow(r, hi);
#pragma unroll
        for (int d0 = 0; d0 < 2; ++d0) stg[orow * 64 + d0 * 32 + r32] = (bf16)f2bf(o[d0][r]); }
    asm volatile("s_waitcnt lgkmcnt(0)" ::: "memory");
#pragma unroll
    for (int i = 0; i < 4; ++i) { const int row = i * 8 + (lane >> 3), ch = lane & 7; const v4u v = *(const LAS v4u*)(stg + row * 64 + ch * 8); if (wt) pg8::st16_wt(Ow + (long)row * D + ch * 8, v); else *(v4u*)(Ow + (long)row * D + ch * 8) = v; }
    asm volatile("s_waitcnt lgkmcnt(0)" ::: "memory");
    __syncthreads();
}

__device__ __forceinline__ void attn_phase(const Frame& F, const Args& a) {
    unsigned char* ws = a.ws;
    const bf16* Q = (const bf16*)(ws + WS_BIG); const bf16* K = (const bf16*)(ws + WS_BIG + 32 * MiB); const bf16* V = (const bf16*)(ws + WS_BIG + 64 * MiB); bf16* O = (bf16*)(ws + WS_BIG);
    const int nslots = (BATCH * H * 2);
    for (int sv = F.vcu; sv < nslots; sv += F.G) {
        const int bh = sv >> 1, odd = sv & 1;
#pragma unroll 1
        for (int i = 0; i < 4; ++i) { const int base = (i == 0) ? 0 : (i == 1) ? 7 : (i == 2) ? 2 : 5; const int qb = odd ? ((i & 1) ? base - 1 : base + 1) : base;
            attn_unit(bh / H, bh % H, qb, Q, K, V, O, F.lds, i == 3 && sv + F.G >= nslots); }
    }
}

#define XB_TMO      128
#define XB_XCNT(j)  (256  + 64 * (j))
#define XB_XSUB(j)  (1280 + 64 * (j))
#define XB_XGEN(j)  (2304 + 64 * (j))
#define XB_TOP      3328
#define XB_TOPGEN   3392
#define XCD_BAR_WORDS 3456
#define XB_SPIN_CAP (1u << 18)

__device__ __forceinline__ unsigned xb_ld(unsigned* p)              { return __hip_atomic_load(p, __ATOMIC_RELAXED, __HIP_MEMORY_SCOPE_AGENT); }
__device__ __forceinline__ unsigned xb_add(unsigned* p, unsigned v) { return __hip_atomic_fetch_add(p, v, __ATOMIC_RELAXED, __HIP_MEMORY_SCOPE_AGENT); }
__device__ __forceinline__ unsigned xb_xcc_id() { return (unsigned)__builtin_amdgcn_s_getreg((3 << 11) | 20) & 0xFu; }
#define XB_SPIN(cond, bar) do { unsigned _sp = 0; while (cond) { \
    if ((++_sp & 255u) == 0u) { if (xb_ld(&(bar)[XB_TMO])) break; if (_sp > XB_SPIN_CAP) { atomicAdd(&(bar)[XB_TMO], 1u); break; } } } } while (0)

struct XcdBarrier {
    unsigned* bar; unsigned x;
    volatile LAS unsigned* st;
};

__device__ __forceinline__ XcdBarrier xcd_barrier_post(unsigned* bar, volatile LAS unsigned* st) {
    XcdBarrier b; b.bar = bar; b.x = xb_xcc_id(); b.st = st;
    if (threadIdx.x == 0) (void)xb_add(&bar[XB_XCNT(b.x)], 1u);
    return b;
}
__device__ __forceinline__ void xcd_barrier_complete(unsigned* bar, unsigned x, unsigned& nloc, unsigned& nx) {
    const unsigned G = gridDim.x * gridDim.y * gridDim.z;
    unsigned sum, cnt, mine, sp = 0u;
    for (;;) {
        sum = 0u; cnt = 0u; mine = 0u;
#pragma unroll
        for (unsigned j = 0; j < 16; ++j) { const unsigned c = xb_ld(&bar[XB_XCNT(j)]); sum += c; cnt += (c > 0u) ? 1u : 0u; mine = (j == x) ? c : mine; }
        if (sum == G) break;
        __builtin_amdgcn_s_sleep(1);
        if ((++sp & 255u) == 0u) { if (xb_ld(&bar[XB_TMO])) break; if (sp > XB_SPIN_CAP) { atomicAdd(&bar[XB_TMO], 1u); break; } }
    }
    nloc = mine > 0u ? mine : 1u; nx = cnt > 0u ? cnt : 1u;
}

__device__ __forceinline__ void xcd_barrier(const XcdBarrier& b) {
    asm volatile("s_waitcnt vmcnt(0)" ::: "memory");
    __syncthreads();
    if (threadIdx.x == 0) {
        unsigned* bar = b.bar;
        __builtin_amdgcn_s_waitcnt(0);
        unsigned nloc = b.st[0], nx = b.st[1];
        if (nloc == 0u) { xcd_barrier_complete(bar, b.x, nloc, nx); b.st[0] = nloc; b.st[1] = nx; }
        const unsigned old = xb_add(&bar[XB_XSUB(b.x)], 1u);
        const unsigned gen = old / nloc;
        if (old + 1u == (gen + 1u) * nloc) {
            __builtin_amdgcn_fence(__ATOMIC_RELEASE, "agent");
            asm volatile("s_waitcnt vmcnt(0)" ::: "memory");
            const unsigned og = xb_add(&bar[XB_TOP], 1u);
            const unsigned tg = og / nx;
            if (og + 1u == (tg + 1u) * nx) xb_add(&bar[XB_TOPGEN], 1u);
            else XB_SPIN(xb_ld(&bar[XB_TOPGEN]) == tg, bar);
            __builtin_amdgcn_fence(__ATOMIC_ACQUIRE, "agent");
            xb_add(&bar[XB_XGEN(b.x)], 1u);
            asm volatile("s_waitcnt vmcnt(0)" ::: "memory");
        } else {
            XB_SPIN(xb_ld(&bar[XB_XGEN(b.x)]) == gen, bar);
            __builtin_amdgcn_fence(__ATOMIC_ACQUIRE, "agent");
            asm volatile("s_waitcnt vmcnt(0)" ::: "memory");
        }
    }
    __syncthreads();
}

enum { ST_PRO = 0, ST_WIN, ST_SGU, ST_WOA, ST_UP0, ST_DN0, ST_PP0, ST_GATE0, ST_QKV, ST_ATT, ST_WOB, ST_UP1, ST_DN1, ST_PP1, ST_GATE1, ST_N };
__host__ __device__ __forceinline__ bool sync_after(int st) { return !(st == ST_PP0 || st == ST_PP1 || st == ST_GATE1); }

template <int ST> __device__ __forceinline__ void run_step(const Args& args, const Frame& F, unsigned char* ws) {
    asm volatile("" : "+s"(ws));
    float* ssq = (float*)(ws + WS_SSQ);
#define SSQ(i) (ssq + (size_t)(i) * M * 16)
    bf16* XB = (bf16*)(ws + WS_XB); bf16* BIG = (bf16*)(ws + WS_BIG); bf16* XB3 = (bf16*)(ws + WS_BIG + 96 * MiB);
    typedef pg8::EpiResT<false> ResN; typedef pg8::EpiResT<true> ResF;
    constexpr int l = (ST >= ST_WOB) ? 1 : 0;
    if constexpr (ST == ST_PRO) prologue_phase(F, args);
    else if constexpr (ST == ST_SGU) sgu_phase(F, args);
    else if constexpr (ST == ST_ATT) attn_phase(F, args);
    else if constexpr (ST == ST_WIN) { const pg8::Gemm g{XB, (const bf16*)(ws + WS_WIN), M, 2 * D, D}; const pg8::EpiAct E{BIG, 2 * D, SSQ(SQ_X0), SSQ(SQ_V), 1};
        pg8::StaticOrder S; S.init(g.M, g.N, F.G, (int)blockIdx.x); pg8::gemm_phase<pg8::EpiAct, pg8::StaticOrder, true, true>(F.lds, g, S, E); }
    else if constexpr (ST == ST_WOA) { const pg8::Gemm g{(const bf16*)(ws + WS_BIG + 64 * MiB), (const bf16*)(ws + WS_WOA), M, D, D}; const ResN E{XB, XB, nullptr, SSQ(SQ_X1), nullptr, nullptr, 0};
        pg8::StaticOrder S; S.init(g.M, g.N, F.G, (int)blockIdx.x); pg8::gemm_phase<ResN, pg8::StaticOrder, true, true>(F.lds, g, S, E); }
    else if constexpr (ST == ST_UP0 || ST == ST_UP1) { const pg8::Gemm g{XB, (const bf16*)(ws + WS_WUP) + (size_t)l * D * FF, M, FF, D}; const pg8::EpiAct E{BIG, FF, SSQ(l ? SQ_X4 : SQ_X1), nullptr, 2};
        pg8::StaticOrder S; S.init(g.M, g.N, F.G, (int)blockIdx.x); pg8::gemm_phase<pg8::EpiAct, pg8::StaticOrder, true, true>(F.lds, g, S, E); }
    else if constexpr (ST == ST_DN0 || ST == ST_DN1) { const pg8::Gemm g{BIG, (const bf16*)(ws + WS_WDN) + (size_t)l * D * FF, M, D, FF}; const ResN E{XB, XB, nullptr, SSQ(l ? SQ_X5 : SQ_X2), nullptr, nullptr, 0};
        pg8::StaticOrder S; S.init(g.M, g.N, F.G, (int)blockIdx.x); pg8::gemm_phase<ResN, pg8::StaticOrder, true, true>(F.lds, g, S, E); }
    else if constexpr (ST == ST_PP0 || ST == ST_PP1) { const pg8::Gemm g{(const bf16*)(ws + WS_PBF) + (size_t)l * M * PLE, (const bf16*)(ws + WS_WPP) + (size_t)l * PLE * D, M, D, PLE}; const pg8::EpiAct E{BIG, D, nullptr, nullptr, 0};
        pg8::StaticOrder S; S.init(g.M, g.N, F.G, (int)blockIdx.x); pg8::gemm_phase<pg8::EpiAct, pg8::StaticOrder, true, true>(F.lds, g, S, E); }
    else if constexpr (ST == ST_GATE0) { const pg8::Gemm g{XB, (const bf16*)(ws + WS_WG), M, D, D}; const ResN E{XB, XB3, nullptr, SSQ(SQ_X3), SSQ(SQ_X2), BIG, 1};
        pg8::StaticOrder S; S.init(g.M, g.N, F.G, (int)blockIdx.x); pg8::gemm_phase<ResN, pg8::StaticOrder, true, true>(F.lds, g, S, E); }
    else if constexpr (ST == ST_GATE1) { const pg8::Gemm g{XB, (const bf16*)(ws + WS_WG) + (size_t)D * D, M, D, D}; const ResF E{XB, nullptr, args.out, nullptr, SSQ(SQ_X5), BIG, 1};
        pg8::StaticOrder S; S.init(g.M, g.N, F.G, (int)blockIdx.x); pg8::gemm_phase<ResF, pg8::StaticOrder, true, true>(F.lds, g, S, E); }
    else if constexpr (ST == ST_QKV) { const pg8::Gemm g{XB3, (const bf16*)(ws + WS_WQKV), M, 3 * D, D}; const pg8::EpiQKV E{BIG, (size_t)M * D, SSQ(SQ_X3), args.in[13], args.in[10]};
        pg8::StaticOrder S; S.init(g.M, g.N, F.G, (int)blockIdx.x); pg8::gemm_phase<pg8::EpiQKV, pg8::StaticOrder, true, true>(F.lds, g, S, E); }
    else if constexpr (ST == ST_WOB) { const pg8::Gemm g{BIG, (const bf16*)(ws + WS_WOB), M, D, D}; const ResN E{XB3, XB, nullptr, SSQ(SQ_X4), nullptr, nullptr, 0};
        pg8::StaticOrder S; S.init(g.M, g.N, F.G, (int)blockIdx.x); pg8::gemm_phase<ResN, pg8::StaticOrder, true, true>(F.lds, g, S, E); }
#undef SSQ
}

__global__ void __launch_bounds__(NWAVES * 64, 2) yoco_fwd(Args args) {
    extern __shared__ __attribute__((aligned(16))) unsigned char lds[];
    cg::grid_group grid = cg::this_grid();
    Frame F; F.lds = (LAS unsigned char*)lds;
    F.G = gridDim.x; { const int bx = blockIdx.x; F.vcu = (F.G % 8 == 0) ? (bx % 8) * (F.G / 8) + bx / 8 : bx; }
    unsigned char* ws = args.ws;
    volatile LAS unsigned* MISC = (volatile LAS unsigned*)(F.lds + 131072 + 320);
    if (threadIdx.x < 32) MISC[threadIdx.x] = 0u;
    __syncthreads();
    XcdBarrier bar = xcd_barrier_post((unsigned*)(ws + WS_CTL) + 4096, MISC + 8);
#define STEP(k) do { if (args.lo <= (k) && (k) < args.hi) { run_step<(k)>(args, F, ws); \
        if ((k) + 1 < args.hi && sync_after(k)) { if (args.hi > 1000) grid.sync(); else xcd_barrier(bar); } else __syncthreads(); } } while (0)
    STEP(0); STEP(1); STEP(2); STEP(3); STEP(4); STEP(5); STEP(6); STEP(7); STEP(8); STEP(9); STEP(10); STEP(11); STEP(12); STEP(13); STEP(14);
#undef STEP
    static_assert(ST_N == 15, "the STEP list covers every step");
}

extern "C" void kernel_launch(void* const* d_in, const int* in_sizes, int n_in, void* d_out, int out_size, void* d_ws, size_t ws_size, hipStream_t stream) {
    static int grid = 0;
    if (grid == 0) {
        if (n_in != 21 || in_sizes[0] != M * D || out_size != M * D || ws_size < WS_END) { fprintf(stderr, "kernel_launch: unexpected shapes (n_in %d, in0 %d, out %d, ws %zu)\n", n_in, n_in > 0 ? in_sizes[0] : -1, out_size, ws_size); grid = -1; return; }
        int dev = 0, cus = 0, per_cu = 0;
        if (hipGetDevice(&dev) != hipSuccess || hipDeviceGetAttribute(&cus, hipDeviceAttributeMultiprocessorCount, dev) != hipSuccess) { grid = -1; return; }
        if (hipFuncSetAttribute((const void*)yoco_fwd, hipFuncAttributeMaxDynamicSharedMemorySize, LDS_BYTES) != hipSuccess) { fprintf(stderr, "kernel_launch: hipFuncSetAttribute failed\n"); grid = -1; return; }
        if (hipOccupancyMaxActiveBlocksPerMultiprocessor(&per_cu, (const void*)yoco_fwd, NWAVES * 64, LDS_BYTES) != hipSuccess || per_cu < 1) { fprintf(stderr, "kernel_launch: occupancy query says %d blocks per CU\n", per_cu); (void)hipGetLastError(); grid = -1; return; }
        grid = cus;
    }
    if (grid < 0) return;
    if (hipMemsetAsync((char*)d_ws + WS_CTL, 0, 65536, stream) != hipSuccess) { fprintf(stderr, "kernel_launch: hipMemsetAsync failed\n"); return; }
    Args a{};
    for (int i = 0; i < 21; ++i) a.in[i] = (const float*)d_in[i];
    a.out = (float*)d_out; a.ws = (unsigned char*)d_ws;
#if MK_SINGLE
    a.lo = 0; a.hi = ST_N;
    void* params[] = {&a};
    hipError_t e = hipLaunchCooperativeKernel((const void*)yoco_fwd, dim3(grid), dim3(NWAVES * 64), params, LDS_BYTES, stream);
    if (e != hipSuccess) fprintf(stderr, "kernel_launch: cooperative launch failed: %s (grid %d)\n", hipGetErrorString(e), grid);
#else
    int lo = 0;
    for (int st = 0; st < ST_N; ++st) {
        if (sync_after(st) || st == ST_N - 1) {
            a.lo = lo; a.hi = st + 1; lo = st + 1;
            void* params[] = {&a};
            hipError_t e = hipLaunchCooperativeKernel((const void*)yoco_fwd, dim3(grid), dim3(NWAVES * 64), params, LDS_BYTES, stream);
            if (e != hipSuccess) { fprintf(stderr, "kernel_launch: launch of steps [%d,%d) failed: %s\n", a.lo, a.hi, hipGetErrorString(e)); break; }
        }
    }
#endif
}
```
